# Optimizing an MI355X kernel written in HIP

```python
import math
import jax, jax.numpy as jnp
from jax import lax
import numpy as np

D_MODEL = 2048
BATCH = 4
SEQ = 4096
DEPTH = 4

N_EVEN = (DEPTH + 1) // 2
N_ODD = DEPTH // 2
RMS_EPS = 1e-6
LN_EPS = 1e-5

SSM_WIDTH = D_MODEL // 2
SSM_GROUP = 16
SSM_GROUPS = SSM_WIDTH // SSM_GROUP
SSM_STATE = 64
DT_MIN = 1e-3
DT_MAX = 1e-1

SG_WIDTH = D_MODEL // 2
SG_CHUNK = 128
SG_HEADS = 8
SG_HEAD_DIM = SG_WIDTH // SG_HEADS

EVEN_IN = 2 * SSM_WIDTH + 3 * SG_WIDTH
EVEN_MIX = SSM_WIDTH + SG_WIDTH

DA_HEADS = 8
DA_HEAD_DIM = D_MODEL // DA_HEADS // 2
DA_V_DIM = 2 * DA_HEAD_DIM
DA_WIDTH = DA_HEADS * DA_V_DIM
ODD_IN = 4 * DA_WIDTH
ROT_DIM = DA_HEAD_DIM // 4
ROPE_THETA = 500000.0
Q_BLOCK = 128

kernel_name = 'hybrid_s5_gmlp_diffattn_trunk'


def rmsnorm(x, g):
    xf = x.astype(jnp.float32)
    y = xf * lax.rsqrt(jnp.mean(xf * xf, axis=-1, keepdims=True) + RMS_EPS)
    return (y * g.astype(jnp.float32)).astype(x.dtype)


def layernorm(x, g, b):
    xf = x.astype(jnp.float32)
    mu = jnp.mean(xf, axis=-1, keepdims=True)
    xc = xf - mu
    y = xc * lax.rsqrt(jnp.mean(xc * xc, axis=-1, keepdims=True) + LN_EPS)
    return (y * g.astype(jnp.float32) + b.astype(jnp.float32)).astype(x.dtype)


def s5_mixer(u, lam_re, lam_im, log_dt, b_re, b_im, c_re, c_im, d_skip):
    f32 = jnp.float32
    dt = jnp.exp(log_dt.astype(f32))[:, None]
    lr = lam_re.astype(f32)
    li = lam_im.astype(f32)
    mag = jnp.exp(lr * dt)
    ab_re = mag * jnp.cos(li * dt)
    ab_im = mag * jnp.sin(li * dt)
    den = lr * lr + li * li
    nr = ab_re - 1.0
    f_re = (nr * lr + ab_im * li) / den
    f_im = (ab_im * lr - nr * li) / den
    br = b_re.astype(f32)
    bi = b_im.astype(f32)
    bb_re = f_re[..., None] * br - f_im[..., None] * bi
    bb_im = f_re[..., None] * bi + f_im[..., None] * br
    uf = u.astype(f32)
    bu_re = jnp.einsum('blgh,gph->blgp', uf, bb_re)
    bu_im = jnp.einsum('blgh,gph->blgp', uf, bb_im)
    seq = u.shape[1]
    a_re = jnp.broadcast_to(ab_re[None, None], (1, seq) + ab_re.shape)
    a_im = jnp.broadcast_to(ab_im[None, None], (1, seq) + ab_im.shape)

    def combine(e1, e2):
        a1r, a1i, b1r, b1i = e1
        a2r, a2i, b2r, b2i = e2
        return (a2r * a1r - a2i * a1i,
                a2r * a1i + a2i * a1r,
                a2r * b1r - a2i * b1i + b2r,
                a2r * b1i + a2i * b1r + b2i)

    _, _, h_re, h_im = lax.associative_scan(combine, (a_re, a_im, bu_re, bu_im), axis=1)
    y = (jnp.einsum('blgp,ghp->blgh', h_re, c_re.astype(f32))
         - jnp.einsum('blgp,ghp->blgh', h_im, c_im.astype(f32))
         + d_skip.astype(f32)[None, None] * uf)
    return y.astype(u.dtype)


def even_layer(x, norm_g, w_in, lam_re, lam_im, log_dt, b_re, b_im, c_re, c_im, d_skip,
               w_glu, b_glu, ln_g, ln_b, w_sp, b_sp, w_out):
    bsz, seq, _ = x.shape
    h = rmsnorm(x, norm_g)
    proj = h @ w_in
    xa, ga, zb, gb = jnp.split(proj, [SSM_WIDTH, 2 * SSM_WIDTH, 2 * SSM_WIDTH + 2 * SG_WIDTH], axis=-1)

    ya = s5_mixer(xa.reshape(bsz, seq, SSM_GROUPS, SSM_GROUP), lam_re, lam_im, log_dt,
                  b_re, b_im, c_re, c_im, d_skip.reshape(SSM_GROUPS, SSM_GROUP))
    ya = jax.nn.gelu(ya.reshape(bsz, seq, SSM_WIDTH))
    ya = ya * jax.nn.sigmoid(ya @ w_glu + b_glu)
    ya = ya * jax.nn.silu(ga)

    zb = jax.nn.gelu(zb)
    u, v = jnp.split(zb, 2, axis=-1)
    v = layernorm(v, ln_g, ln_b)
    vc = v.reshape(bsz, seq // SG_CHUNK, SG_CHUNK, SG_HEADS, SG_HEAD_DIM)
    causal = jnp.tril(jnp.ones((SG_CHUNK, SG_CHUNK), dtype=bool))
    w_c = jnp.where(causal[None], w_sp, jnp.zeros((), w_sp.dtype))
    s = jnp.einsum('gts,bnsgc->bntgc', w_c, vc) + b_sp.T[:, :, None]
    yb = u * s.reshape(bsz, seq, SG_WIDTH) * jax.nn.silu(gb)

    y = jnp.concatenate([ya, yb], axis=-1) @ w_out
    return x + y


def partial_rope(t, cos, sin):
    tr = t[..., :ROT_DIM]
    tp = t[..., ROT_DIM:]
    t1, t2 = jnp.split(tr, 2, axis=-1)
    c = cos[None, :, None, None, :]
    s = sin[None, :, None, None, :]
    rot = jnp.concatenate([t1 * c - t2 * s, t2 * c + t1 * s], axis=-1)
    return jnp.concatenate([rot, tp], axis=-1)


def odd_layer(x, norm_g, w_in, lq1, lk1, lq2, lk2, subln_g, w_out, lambda_init):
    bsz, seq, _ = x.shape
    f32 = jnp.float32
    h = rmsnorm(x, norm_g)
    proj = h @ w_in
    q, k, v, g = jnp.split(proj, 4, axis=-1)
    q = q.reshape(bsz, seq, DA_HEADS, 2, DA_HEAD_DIM)
    k = k.reshape(bsz, seq, DA_HEADS, 2, DA_HEAD_DIM)
    v = v.reshape(bsz, seq, DA_HEADS, DA_V_DIM)

    pos = jnp.arange(seq, dtype=f32)
    inv_freq = ROPE_THETA ** (-jnp.arange(0, ROT_DIM, 2, dtype=f32) / ROT_DIM)
    ang = pos[:, None] * inv_freq[None, :]
    cos = jnp.cos(ang).astype(q.dtype)
    sin = jnp.sin(ang).astype(q.dtype)
    q = partial_rope(q, cos, sin)
    k = partial_rope(k, cos, sin)

    lam = (jnp.exp(jnp.sum(lq1.astype(f32) * lk1.astype(f32)))
           - jnp.exp(jnp.sum(lq2.astype(f32) * lk2.astype(f32))) + lambda_init)
    scale = DA_HEAD_DIM ** -0.5
    n_blocks = seq // Q_BLOCK
    qb = q.reshape(bsz, n_blocks, Q_BLOCK, DA_HEADS, 2, DA_HEAD_DIM).transpose(1, 0, 2, 3, 4, 5)
    kpos = jnp.arange(seq)

    def attend_block(args):
        q_blk, blk = args
        sc = jnp.einsum('bqhjd,bkhjd->bhjqk', q_blk, k).astype(f32) * scale
        qpos = blk * Q_BLOCK + jnp.arange(Q_BLOCK)
        mask = kpos[None, :] <= qpos[:, None]
        sc = jnp.where(mask, sc, -jnp.inf)
        p = jax.nn.softmax(sc, axis=-1)
        a = p[:, :, 0] - lam * p[:, :, 1]
        return jnp.einsum('bhqk,bkhe->bqhe', a.astype(v.dtype), v)

    o = lax.map(attend_block, (qb, jnp.arange(n_blocks)))
    o = o.transpose(1, 0, 2, 3, 4).reshape(bsz, seq, DA_HEADS, DA_V_DIM)
    o = rmsnorm(o, subln_g) * (1.0 - lambda_init)
    o = o.reshape(bsz, seq, DA_WIDTH) * jax.nn.silu(g)
    return x + o @ w_out


def setup_inputs(seed: int = 0) -> dict:
    key = jax.random.key(seed)
    keys = list(jax.random.split(key, 32))
    f32 = jnp.float32

    def nrm(shape, std):
        return std * jax.random.normal(keys.pop(), shape, f32)

    ne, no = N_EVEN, N_ODD
    G, P, H = SSM_GROUPS, SSM_STATE, SSM_GROUP
    x = jax.random.normal(keys.pop(), (BATCH, SEQ, D_MODEL), f32)
    ev_norm = 1.0 + nrm((ne, D_MODEL), 0.02)
    ev_w_in = nrm((ne, D_MODEL, EVEN_IN), D_MODEL ** -0.5)
    n_idx = jnp.arange(SSM_STATE, dtype=f32)
    ssm_lam_re = -0.5 + nrm((ne, G, P), 0.01)
    ssm_lam_im = math.pi * n_idx + nrm((ne, G, P), 0.01)
    ssm_log_dt = jax.random.uniform(keys.pop(), (ne, G), f32, math.log(DT_MIN), math.log(DT_MAX))
    ssm_b_re = nrm((ne, G, P, H), (2 * H) ** -0.5)
    ssm_b_im = nrm((ne, G, P, H), (2 * H) ** -0.5)
    ssm_c_re = nrm((ne, G, H, P), P ** -0.5)
    ssm_c_im = nrm((ne, G, H, P), P ** -0.5)
    ssm_d = nrm((ne, SSM_WIDTH), 1.0)
    ssm_w_glu = nrm((ne, SSM_WIDTH, SSM_WIDTH), SSM_WIDTH ** -0.5)
    ssm_b_glu = nrm((ne, SSM_WIDTH), 0.02)
    sg_ln_g = 1.0 + nrm((ne, SG_WIDTH), 0.02)
    sg_ln_b = nrm((ne, SG_WIDTH), 0.02)
    sg_w_sp = nrm((ne, SG_HEADS, SG_CHUNK, SG_CHUNK), SG_CHUNK ** -0.5)
    sg_b_sp = 1.0 + nrm((ne, SG_HEADS, SG_CHUNK), 0.02)
    ev_w_out = nrm((ne, EVEN_MIX, D_MODEL), EVEN_MIX ** -0.5)
    od_norm = 1.0 + nrm((no, D_MODEL), 0.02)
    od_w_in = nrm((no, D_MODEL, ODD_IN), D_MODEL ** -0.5)
    da_lq1 = nrm((no, DA_HEAD_DIM), 0.1)
    da_lk1 = nrm((no, DA_HEAD_DIM), 0.1)
    da_lq2 = nrm((no, DA_HEAD_DIM), 0.1)
    da_lk2 = nrm((no, DA_HEAD_DIM), 0.1)
    da_subln = 1.0 + nrm((no, DA_V_DIM), 0.02)
    od_w_out = nrm((no, DA_WIDTH, D_MODEL), DA_WIDTH ** -0.5)
    final_norm = 1.0 + nrm((D_MODEL,), 0.02)
    return {'x': x, 'ev_norm': ev_norm, 'ev_w_in': ev_w_in,
            'ssm_lam_re': ssm_lam_re, 'ssm_lam_im': ssm_lam_im, 'ssm_log_dt': ssm_log_dt,
            'ssm_b_re': ssm_b_re, 'ssm_b_im': ssm_b_im, 'ssm_c_re': ssm_c_re, 'ssm_c_im': ssm_c_im,
            'ssm_d': ssm_d, 'ssm_w_glu': ssm_w_glu, 'ssm_b_glu': ssm_b_glu,
            'sg_ln_g': sg_ln_g, 'sg_ln_b': sg_ln_b, 'sg_w_sp': sg_w_sp, 'sg_b_sp': sg_b_sp,
            'ev_w_out': ev_w_out, 'od_norm': od_norm, 'od_w_in': od_w_in,
            'da_lq1': da_lq1, 'da_lk1': da_lk1, 'da_lq2': da_lq2, 'da_lk2': da_lk2,
            'da_subln': da_subln, 'od_w_out': od_w_out, 'final_norm': final_norm}


def reference(x, ev_norm, ev_w_in, ssm_lam_re, ssm_lam_im, ssm_log_dt, ssm_b_re, ssm_b_im,
              ssm_c_re, ssm_c_im, ssm_d, ssm_w_glu, ssm_b_glu, sg_ln_g, sg_ln_b, sg_w_sp, sg_b_sp,
              ev_w_out, od_norm, od_w_in, da_lq1, da_lk1, da_lq2, da_lk2, da_subln, od_w_out,
              final_norm):
    for i in range(DEPTH):
        j = i // 2
        if i % 2 == 0:
            x = even_layer(x, ev_norm[j], ev_w_in[j], ssm_lam_re[j], ssm_lam_im[j], ssm_log_dt[j],
                           ssm_b_re[j], ssm_b_im[j], ssm_c_re[j], ssm_c_im[j], ssm_d[j],
                           ssm_w_glu[j], ssm_b_glu[j], sg_ln_g[j], sg_ln_b[j], sg_w_sp[j], sg_b_sp[j],
                           ev_w_out[j])
        else:
            lambda_init = 0.8 - 0.6 * math.exp(-0.3 * i)
            x = odd_layer(x, od_norm[j], od_w_in[j], da_lq1[j], da_lk1[j], da_lq2[j], da_lk2[j],
                          da_subln[j], od_w_out[j], lambda_init)
    return rmsnorm(x, final_norm)
```

```cpp
#include <hip/hip_runtime.h>
#include <cstdio>
#include <cstdint>
#include <cmath>
namespace pg8 {
#define PG8_LAS __attribute__((address_space(3)))
typedef unsigned short bf16_t;
typedef short bf16x8 __attribute__((ext_vector_type(8)));
typedef float f32x4 __attribute__((ext_vector_type(4)));
typedef unsigned u32x4 __attribute__((ext_vector_type(4)));
constexpr int BM = 256, BK = 64, HALF = 128, HTB = HALF * BK * 2  , STAGE_BYTES = 8 * HTB, NXCD = 8, WGM = 8;

__host__ __device__ __forceinline__ int lds_byte(int r, int c) { const int st = (r >> 4) * 2 + (c >> 5), rr = r & 15, cc = c & 31, ob = rr * 64 + cc * 2; return st * 1024 + (ob ^ (((ob >> 9) & 1) << 5)); }
__host__ __device__ __forceinline__ void stage_rc(int b, int& R, int& C) { const int st = b / 1024, sb = b % 1024, swz = sb ^ (((sb >> 9) & 1) << 5); R = (st >> 1) * 16 + swz / 64; C = (st & 1) * 32 + (swz % 64) / 2; }
__host__ __device__ __forceinline__ int perm32(int rho) { const int n = rho >> 4, i = rho & 15; return 8 * (i >> 2) + 4 * n + (i & 3); }

struct Unit { int pm, pn; };
struct Gemm { const bf16_t* A; const bf16_t* Bt; int M, N, K, lda; };

struct StaticOrder {
    int nM, nN, nwg, G, c;
    __host__ __device__ void init(int M, int N, int G_, int c_) { nM = M / BM; nN = N / BM; nwg = nM * nN; G = G_; c = c_; }
    __host__ __device__ bool next(int i, Unit& u) const {
        const long L = (long)i * G + c; if (L >= nwg) return false;
        int wgid = (int)L; { const int q = nwg / NXCD, r = nwg % NXCD, xcd = wgid % NXCD, off = wgid / NXCD; wgid = (xcd < r ? xcd * (q + 1) : r * (q + 1) + (xcd - r) * q) + off; }
        const int nig = WGM * nN, gid = wgid / nig, fm = gid * WGM, gsz = (nM - fm) < WGM ? (nM - fm) : WGM;
        u.pm = fm + ((wgid % nig) % gsz); u.pn = (wgid % nig) / gsz; return true;
    }
    __device__ __forceinline__ void a_ready(const Unit&) const {}
    __device__ __forceinline__ void done(const Unit&) const {}
};

__device__ __forceinline__ unsigned cvt_pk_bf16(float lo, float hi) { unsigned r; asm volatile("v_cvt_pk_bf16_f32 %0, %1, %2" : "=v"(r) : "v"(lo), "v"(hi)); return r; }
typedef float f32x2 __attribute__((ext_vector_type(2)));
__device__ __forceinline__ float silu_f(float v) { return v * __builtin_amdgcn_rcpf(1.f + __expf(-v)); }
__device__ __forceinline__ float sigmoid_f(float v) { return __builtin_amdgcn_rcpf(1.f + __expf(-v)); }
__device__ __forceinline__ float gelu_tanh_f(float v) { const float u = 0.7978845608028654f * (v + 0.044715f * v * v * v); return v * __builtin_amdgcn_rcpf(1.f + __expf(-2.f * u)); }
__device__ __forceinline__ float bf2f(unsigned short b) { return __uint_as_float(((unsigned)b) << 16); }
__device__ __forceinline__ float bflo(unsigned w) { return __uint_as_float(w << 16); }
__device__ __forceinline__ float bfhi(unsigned w) { return __uint_as_float(w & 0xffff0000u); }

struct EpiEvenProj {
    static constexpr bool PERM = true, AFTER_DRAIN = false;
    bf16_t* O; const float* ssq; bf16_t* xa2;
    __device__ __forceinline__ void operator()(const f32x4 (&acc)[2][2][4][2], const Unit& u, int wr, int wc, int fr, int fq) const {
        const int row0 = u.pm * BM + wr * 64 + fr, col0 = u.pn * BM + wc * 32 + 8 * fq;
        const int act = (u.pn < 4) ? 0 : (u.pn < 8) ? 1 : (u.pn < 16) ? 2 : 1;
        float rsv[2][4];
#pragma unroll
        for (int ai = 0; ai < 2; ++ai)
#pragma unroll
            for (int m = 0; m < 4; ++m) rsv[ai][m] = ssq[row0 + ai * HALF + m * 16];
#pragma unroll
        for (int ai = 0; ai < 2; ++ai)
#pragma unroll
            for (int m = 0; m < 4; ++m) rsv[ai][m] = rsqrtf(rsv[ai][m] * (1.f / 2048.f) + 1e-6f);
#pragma unroll
        for (int ai = 0; ai < 2; ++ai)
#pragma unroll
            for (int m = 0; m < 4; ++m) { bf16_t* rowp = O + (size_t)(row0 + ai * HALF + m * 16) * 5120 + col0; const float rs = rsv[ai][m];
#pragma unroll
                for (int bj = 0; bj < 2; ++bj) { f32x4 v0 = acc[ai][bj][m][0] * rs, v1 = acc[ai][bj][m][1] * rs;
                    if (act == 1) {
#pragma unroll
                        for (int e = 0; e < 4; ++e) { v0[e] = silu_f(v0[e]); v1[e] = silu_f(v1[e]); } }
                    else if (act == 2) {
#pragma unroll
                        for (int e = 0; e < 4; ++e) { v0[e] = gelu_tanh_f(v0[e]); v1[e] = gelu_tanh_f(v1[e]); } }
                    u32x4 w; w.x = cvt_pk_bf16(v0[0], v0[1]); w.y = cvt_pk_bf16(v0[2], v0[3]); w.z = cvt_pk_bf16(v1[0], v1[1]); w.w = cvt_pk_bf16(v1[2], v1[3]);
                    if (act == 0) { const int rr = row0 + ai * HALF + m * 16, cc = col0 + bj * HALF;
                        *(u32x4*)(xa2 + ((size_t)((rr >> 12) * 64 + (cc >> 4)) * 4096 + (rr & 4095)) * 16 + (cc & 8)) = w; }
                    else *(u32x4*)(rowp + bj * HALF) = w; } }
    }
};
struct EpiOddProj {
    static constexpr bool PERM = true, AFTER_DRAIN = false;
    bf16_t* O; const float* cs; const float* ssq;
    __device__ __forceinline__ void operator()(const f32x4 (&acc)[2][2][4][2], const Unit& u, int wr, int wc, int fr, int fq) const {
        const int row0 = u.pm * BM + wr * 64 + fr, col0 = u.pn * BM + wc * 32 + 8 * fq;
        const int kind = u.pn >> 3;
        const float C2 = 0.08838834764831845f * 1.4426950408889634f;
        const float sgn = (fq < 2) ? -1.f : 1.f; const int fi = 8 * (fq & 1);
        float rsv[2][4];
#pragma unroll
        for (int ai = 0; ai < 2; ++ai)
#pragma unroll
            for (int m = 0; m < 4; ++m) rsv[ai][m] = ssq[row0 + ai * HALF + m * 16];
#pragma unroll
        for (int ai = 0; ai < 2; ++ai)
#pragma unroll
            for (int m = 0; m < 4; ++m) rsv[ai][m] = rsqrtf(rsv[ai][m] * (1.f / 2048.f) + 1e-6f);
        const bool rope = (kind < 2) && (wc == 0);
#pragma unroll
        for (int ah = 0; ah < 4; ++ah) { const int ai = ah >> 1;
            f32x4 ct[2][4];
            if (rope) {
#pragma unroll
                for (int mm = 0; mm < 2; ++mm) { const int pos = (row0 + ai * HALF + (2 * (ah & 1) + mm) * 16) & 4095;
                    ct[mm][0] = *(const f32x4*)(cs + pos * 16 + fi); ct[mm][1] = *(const f32x4*)(cs + pos * 16 + fi + 4);
                    ct[mm][2] = *(const f32x4*)(cs + 65536 + pos * 16 + fi); ct[mm][3] = *(const f32x4*)(cs + 65536 + pos * 16 + fi + 4); }
            }
#pragma unroll
            for (int mm = 0; mm < 2; ++mm) { const int m = 2 * (ah & 1) + mm; const int row = row0 + ai * HALF + m * 16; bf16_t* rowp = O + (size_t)row * 8192 + col0; const float rs = rsv[ai][m];
#pragma unroll
                for (int bj = 0; bj < 2; ++bj) { f32x4 v0 = acc[ai][bj][m][0] * rs, v1 = acc[ai][bj][m][1] * rs;
                    if (kind < 2) {
                        if (wc == 0) {
                            f32x4 p0, p1;
#pragma unroll
                            for (int e = 0; e < 4; ++e) { p0[e] = __shfl_xor(v0[e], 32); p1[e] = __shfl_xor(v1[e], 32); }
                            const f32x4 c0 = ct[mm][0], c1 = ct[mm][1], s0 = ct[mm][2], s1 = ct[mm][3];
                            v0 = v0 * c0 + (p0 * s0) * sgn; v1 = v1 * c1 + (p1 * s1) * sgn;
                        }
                        if (kind == 0) { v0 = v0 * C2; v1 = v1 * C2; }
                    } else if (kind == 3) {
#pragma unroll
                        for (int e = 0; e < 4; ++e) { v0[e] = silu_f(v0[e]); v1[e] = silu_f(v1[e]); } }
                    u32x4 w; w.x = cvt_pk_bf16(v0[0], v0[1]); w.y = cvt_pk_bf16(v0[2], v0[3]); w.z = cvt_pk_bf16(v1[0], v1[1]); w.w = cvt_pk_bf16(v1[2], v1[3]);
                    *(u32x4*)(rowp + bj * HALF) = w; } }
        }
    }
};
struct EpiGlu {
    static constexpr bool PERM = true, AFTER_DRAIN = false;
    const bf16_t* yap; const bf16_t* proj; const float* bglu; bf16_t* mix;
    __device__ __forceinline__ void operator()(const f32x4 (&acc)[2][2][4][2], const Unit& u, int wr, int wc, int fr, int fq) const {
        const int row0 = u.pm * BM + wr * 64 + fr, col0 = u.pn * BM + wc * 32 + 8 * fq;
        f32x4 bb[2][2];
#pragma unroll
        for (int bj = 0; bj < 2; ++bj) { bb[bj][0] = *(const f32x4*)(bglu + col0 + bj * HALF); bb[bj][1] = *(const f32x4*)(bglu + col0 + bj * HALF + 4); }
#pragma unroll
        for (int ai = 0; ai < 2; ++ai) {
            u32x4 yv[4][2], gv[4][2];
#pragma unroll
            for (int m = 0; m < 4; ++m)
#pragma unroll
                for (int bj = 0; bj < 2; ++bj) { const size_t row = (size_t)(row0 + ai * HALF + m * 16); const int c = col0 + bj * HALF;
                    yv[m][bj] = *(const u32x4*)(yap + row * 1024 + c); gv[m][bj] = *(const u32x4*)(proj + row * 5120 + 1024 + c); }
#pragma unroll
            for (int m = 0; m < 4; ++m) { const size_t row = (size_t)(row0 + ai * HALF + m * 16);
#pragma unroll
                for (int bj = 0; bj < 2; ++bj) { const int c = col0 + bj * HALF;
                    const u32x4 y8 = yv[m][bj], g8 = gv[m][bj];
                    const f32x4 a0 = acc[ai][bj][m][0] + bb[bj][0], a1 = acc[ai][bj][m][1] + bb[bj][1];
                    float o[8];
                    o[0] = bflo(y8.x) * sigmoid_f(a0[0]) * bflo(g8.x); o[1] = bfhi(y8.x) * sigmoid_f(a0[1]) * bfhi(g8.x);
                    o[2] = bflo(y8.y) * sigmoid_f(a0[2]) * bflo(g8.y); o[3] = bfhi(y8.y) * sigmoid_f(a0[3]) * bfhi(g8.y);
                    o[4] = bflo(y8.z) * sigmoid_f(a1[0]) * bflo(g8.z); o[5] = bfhi(y8.z) * sigmoid_f(a1[1]) * bfhi(g8.z);
                    o[6] = bflo(y8.w) * sigmoid_f(a1[2]) * bflo(g8.w); o[7] = bfhi(y8.w) * sigmoid_f(a1[3]) * bfhi(g8.w);
                    u32x4 w; w.x = cvt_pk_bf16(o[0], o[1]); w.y = cvt_pk_bf16(o[2], o[3]); w.z = cvt_pk_bf16(o[4], o[5]); w.w = cvt_pk_bf16(o[6], o[7]);
                    *(u32x4*)(mix + row * 5120 + c) = w; } }
        }
    }
};
struct EpiResid {
    static constexpr bool PERM = false, AFTER_DRAIN = false;
    const float* base; float* out;
    __device__ __forceinline__ void operator()(const f32x4 (&acc)[2][2][4][2], const Unit& u, int wr, int wc, int fr, int fq) const {
        const int row0 = u.pm * BM + wr * 64 + fr, col0 = u.pn * BM + wc * 32 + 4 * fq;
#pragma unroll
        for (int ai = 0; ai < 2; ++ai) {
            f32x4 bv[4][2][2];
#pragma unroll
            for (int m = 0; m < 4; ++m) { const size_t off = (size_t)(row0 + ai * HALF + m * 16) * 2048 + col0;
#pragma unroll
                for (int bj = 0; bj < 2; ++bj)
#pragma unroll
                    for (int n = 0; n < 2; ++n) bv[m][bj][n] = *(const f32x4*)(base + off + bj * HALF + n * 16); }
#pragma unroll
            for (int m = 0; m < 4; ++m) { const size_t off = (size_t)(row0 + ai * HALF + m * 16) * 2048 + col0;
#pragma unroll
                for (int bj = 0; bj < 2; ++bj)
#pragma unroll
                    for (int n = 0; n < 2; ++n) *(f32x4*)(out + off + bj * HALF + n * 16) = bv[m][bj][n] + acc[ai][bj][m][n]; }
        }
    }
};
struct EpiResidStat {
    static constexpr bool PERM = false, AFTER_DRAIN = false;
    const float* base; float* out; bf16_t* xb; float* ssq;
    __device__ __forceinline__ void operator()(const f32x4 (&acc)[2][2][4][2], const Unit& u, int wr, int wc, int fr, int fq) const {
        const int row0 = u.pm * BM + wr * 64 + fr, col0 = u.pn * BM + wc * 32 + 4 * fq;
        typedef unsigned u32x2_t __attribute__((ext_vector_type(2)));
#pragma unroll
        for (int ai = 0; ai < 2; ++ai) {
            f32x4 bv[4][2][2];
#pragma unroll
            for (int m = 0; m < 4; ++m) { const size_t off = (size_t)(row0 + ai * HALF + m * 16) * 2048 + col0;
#pragma unroll
                for (int bj = 0; bj < 2; ++bj)
#pragma unroll
                    for (int n = 0; n < 2; ++n) bv[m][bj][n] = *(const f32x4*)(base + off + bj * HALF + n * 16); }
            float sqv[4];
#pragma unroll
            for (int m = 0; m < 4; ++m) { const int row = row0 + ai * HALF + m * 16; const size_t off = (size_t)row * 2048 + col0; float sq = 0.f;
#pragma unroll
                for (int bj = 0; bj < 2; ++bj)
#pragma unroll
                    for (int n = 0; n < 2; ++n) { const f32x4 o = bv[m][bj][n] + acc[ai][bj][m][n];
                        *(f32x4*)(out + off + bj * HALF + n * 16) = o; sq += (o[0] * o[0] + o[1] * o[1]) + (o[2] * o[2] + o[3] * o[3]);
                        u32x2_t w; w.x = cvt_pk_bf16(o[0], o[1]); w.y = cvt_pk_bf16(o[2], o[3]); *(u32x2_t*)(xb + off + bj * HALF + n * 16) = w; }
                sqv[m] = sq; }
#pragma unroll
            for (int m = 0; m < 4; ++m) { sqv[m] += __shfl_xor(sqv[m], 16); }
#pragma unroll
            for (int m = 0; m < 4; ++m) { sqv[m] += __shfl_xor(sqv[m], 32); }
#pragma unroll
            for (int m = 0; m < 4; ++m) if (fq == 0) atomicAdd(ssq + row0 + ai * HALF + m * 16, sqv[m]);
        }
    }
};

template <class Epi, class Sched, bool ALIGN_EPI = false, bool SP2 = false>
__device__ __forceinline__ void gemm_phase(PG8_LAS unsigned char* lds, const Gemm g, const Sched& S, const Epi& E, const int tid_in) {
    const int tid = tid_in, wid = __builtin_amdgcn_readfirstlane(tid >> 6), lane = tid & 63, wr = wid >> 2, wc = wid & 3, fr = lane & 15, fq = lane >> 4;
    const int K = g.K, nt = K / BK;
    unsigned voffA[2], voffB[2];
#pragma unroll
    for (int i = 0; i < 2; ++i) { int R, C; stage_rc(tid * 16 + i * 8192, R, C); const int Rb = Epi::PERM ? ((R & ~31) + perm32(R & 31)) : R;
        voffA[i] = (unsigned)(R * g.lda + C) * 2u; voffB[i] = (unsigned)(Rb * K + C) * 2u; }
    const size_t kstep = (size_t)(BK * 2);
    const size_t hstep = (size_t)HALF * K * 2;
    const size_t tstep = 2 * hstep;
    const size_t hstepA = (size_t)HALF * g.lda * 2, tstepA = 2 * hstepA;
    const unsigned ldsw = (unsigned)wid * 1024u;
    const int aoff = lds_byte(wr * 64 + fr, fq * 8), boff = lds_byte(wc * 32 + fr, fq * 8);
#define PG8_SA(b, h) (((b) * 2 + (h)) * HTB)
#define PG8_SB(b, h) ((4 + (b) * 2 + (h)) * HTB)
#define PG8_STAGE(bufoff, gbase, voff) do { _Pragma("unroll") for (int _i = 0; _i < 2; ++_i) \
        __builtin_amdgcn_global_load_lds((const unsigned*)((const char*)(gbase) + (voff)[_i]), (PG8_LAS unsigned*)(lds + (bufoff) + ldsw + _i * 8192), 16, 0, 0); } while (0)
#define PG8_LDA(dst, b, h) do { _Pragma("unroll") for (int m = 0; m < 4; ++m) _Pragma("unroll") for (int k = 0; k < 2; ++k) dst[m][k] = *(const PG8_LAS bf16x8*)(lds + PG8_SA(b, h) + aoff + m * 2048 + k * 1024); } while (0)
#define PG8_LDB(dst, b, h) do { _Pragma("unroll") for (int n = 0; n < 2; ++n) _Pragma("unroll") for (int k = 0; k < 2; ++k) dst[n][k] = *(const PG8_LAS bf16x8*)(lds + PG8_SB(b, h) + boff + n * 2048 + k * 1024); } while (0)
#define PG8_MMA(ai, bj, At, Bt) do { __builtin_amdgcn_s_setprio(1); _Pragma("unroll") for (int m = 0; m < 4; ++m) _Pragma("unroll") for (int n = 0; n < 2; ++n) _Pragma("unroll") for (int k = 0; k < 2; ++k) \
        acc[ai][bj][m][n] = __builtin_amdgcn_mfma_f32_16x16x32_bf16(Bt[n][k], At[m][k], acc[ai][bj][m][n], 0, 0, 0); __builtin_amdgcn_s_setprio(0); } while (0)
#define PG8_WAIT_V(n) asm volatile("s_waitcnt vmcnt(" #n ")" ::: "memory")
#define PG8_WAIT_L(n) asm volatile("s_waitcnt lgkmcnt(" #n ")" ::: "memory")
#define PG8_BAR __builtin_amdgcn_s_barrier()
#define PG8_SCHED __builtin_amdgcn_sched_barrier(0)
    Unit cur, nxt; int ui = 0;
    if (!S.next(0, cur)) return;
    f32x4 acc[2][2][4][2];
#pragma unroll
    for (int a = 0; a < 2; ++a)
#pragma unroll
        for (int b = 0; b < 2; ++b)
#pragma unroll
            for (int m = 0; m < 4; ++m)
#pragma unroll
                for (int n = 0; n < 2; ++n) acc[a][b][m][n] = (f32x4){0.f, 0.f, 0.f, 0.f};
    bf16x8 At[4][2], B0[2][2], B1[2][2];
    const char* cA = (const char*)g.A + (size_t)cur.pm * tstepA; const char* cB = (const char*)g.Bt + (size_t)cur.pn * tstep;
    S.a_ready(cur);
    if constexpr (SP2) {
        PG8_STAGE(PG8_SB(0, 0), cB, voffB); PG8_STAGE(PG8_SB(0, 1), cB + hstep, voffB); PG8_STAGE(PG8_SA(0, 0), cA, voffA); PG8_STAGE(PG8_SA(0, 1), cA + hstepA, voffA);
        if (wr == 1) PG8_BAR;
        PG8_WAIT_V(2); PG8_BAR;
        PG8_STAGE(PG8_SB(1, 0), cB + kstep, voffB); PG8_STAGE(PG8_SA(1, 0), cA + kstep, voffA); PG8_STAGE(PG8_SB(1, 1), cB + hstep + kstep, voffB);
        PG8_WAIT_V(6); PG8_BAR;
    } else {
        PG8_STAGE(PG8_SB(0, 0), cB, voffB); PG8_STAGE(PG8_SA(0, 0), cA, voffA); PG8_STAGE(PG8_SB(0, 1), cB + hstep, voffB); PG8_STAGE(PG8_SA(0, 1), cA + hstepA, voffA);
        if (wr == 1) PG8_BAR;
        PG8_WAIT_V(4); PG8_BAR;
        PG8_STAGE(PG8_SB(1, 0), cB + kstep, voffB); PG8_STAGE(PG8_SA(1, 0), cA + kstep, voffA); PG8_STAGE(PG8_SB(1, 1), cB + hstep + kstep, voffB);
        PG8_WAIT_V(6); PG8_BAR;
    }
    for (;;) {
        const bool has_next = S.next(ui + 1, nxt);
        const char* nA = has_next ? (const char*)g.A + (size_t)nxt.pm * tstepA : cA; const char* nB = has_next ? (const char*)g.Bt + (size_t)nxt.pn * tstep : cB;
        for (int t = 0; t < nt; t += 2) {
            const bool last = (t == nt - 2);
            const char* a1 = cA + (size_t)(t + 1) * kstep;
            const char* a2 = last ? nA : cA + (size_t)(t + 2) * kstep; const char* b2 = last ? nB : cB + (size_t)(t + 2) * kstep;
            const char* a3 = a2 + kstep; const char* b3 = b2 + kstep;
            if (last && has_next) S.a_ready(nxt);
            if constexpr (SP2) {
            PG8_LDB(B0, 0, 0); PG8_LDB(B1, 0, 1); PG8_SCHED; PG8_LDA(At, 0, 0); PG8_STAGE(PG8_SA(1, 1), a1 + hstepA, voffA);
            PG8_WAIT_V(8); PG8_WAIT_L(0); PG8_BAR; PG8_MMA(0, 0, At, B0); PG8_MMA(0, 1, At, B1); PG8_BAR; PG8_SCHED;
            PG8_LDA(At, 0, 1); PG8_STAGE(PG8_SB(0, 0), b2, voffB); PG8_STAGE(PG8_SB(0, 1), b2 + hstep, voffB); PG8_STAGE(PG8_SA(0, 0), a2, voffA);
            PG8_WAIT_V(8); PG8_WAIT_L(0); PG8_BAR; PG8_MMA(1, 0, At, B0); PG8_MMA(1, 1, At, B1); PG8_BAR; PG8_SCHED;
            PG8_LDB(B0, 1, 0); PG8_LDB(B1, 1, 1); PG8_SCHED; PG8_LDA(At, 1, 0); PG8_STAGE(PG8_SA(0, 1), a2 + hstepA, voffA);
            PG8_WAIT_V(8); PG8_WAIT_L(0); PG8_BAR; PG8_MMA(0, 0, At, B0); PG8_MMA(0, 1, At, B1); PG8_BAR; PG8_SCHED;
            PG8_LDA(At, 1, 1); PG8_STAGE(PG8_SB(1, 0), b3, voffB); PG8_STAGE(PG8_SB(1, 1), b3 + hstep, voffB); PG8_STAGE(PG8_SA(1, 0), a3, voffA);
            PG8_WAIT_V(8); PG8_WAIT_L(0); PG8_BAR; PG8_MMA(1, 0, At, B0); PG8_MMA(1, 1, At, B1); PG8_BAR; PG8_SCHED;
            } else {
            PG8_LDB(B0, 0, 0); PG8_SCHED; PG8_LDA(At, 0, 0); PG8_STAGE(PG8_SA(1, 1), a1 + hstepA, voffA);
            PG8_WAIT_L(8); PG8_BAR; PG8_WAIT_L(0); PG8_MMA(0, 0, At, B0); PG8_BAR; PG8_SCHED;
            PG8_LDB(B1, 0, 1); PG8_STAGE(PG8_SB(0, 0), b2, voffB);
            PG8_BAR; PG8_WAIT_L(0); PG8_MMA(0, 1, At, B1); PG8_BAR;
            PG8_LDA(At, 0, 1); PG8_STAGE(PG8_SA(0, 0), a2, voffA);
            PG8_BAR; PG8_WAIT_L(0); PG8_MMA(1, 0, At, B0); PG8_BAR; PG8_SCHED;
            PG8_STAGE(PG8_SB(0, 1), b2 + hstep, voffB);
            PG8_WAIT_V(6); PG8_BAR; PG8_MMA(1, 1, At, B1); PG8_BAR;
            PG8_LDB(B0, 1, 0); PG8_SCHED; PG8_LDA(At, 1, 0); PG8_STAGE(PG8_SA(0, 1), a2 + hstepA, voffA);
            PG8_WAIT_L(8); PG8_BAR; PG8_WAIT_L(0); PG8_MMA(0, 0, At, B0); PG8_BAR; PG8_SCHED;
            PG8_LDB(B1, 1, 1); PG8_STAGE(PG8_SB(1, 0), b3, voffB);
            PG8_BAR; PG8_WAIT_L(0); PG8_MMA(0, 1, At, B1); PG8_BAR;
            PG8_LDA(At, 1, 1); PG8_STAGE(PG8_SA(1, 0), a3, voffA);
            PG8_BAR; PG8_WAIT_L(0); PG8_MMA(1, 0, At, B0); PG8_BAR; PG8_SCHED;
            PG8_STAGE(PG8_SB(1, 1), b3 + hstep, voffB);
            PG8_WAIT_V(6); PG8_BAR; PG8_MMA(1, 1, At, B1); PG8_BAR;
            }
        }
        if constexpr (ALIGN_EPI) { if (wr == 0) PG8_BAR; }
        if constexpr (!Epi::AFTER_DRAIN) { E(acc, cur, wr, wc, fr, fq); S.done(cur); }
        if (!has_next) break;
#pragma unroll
        for (int a = 0; a < 2; ++a)
#pragma unroll
            for (int b = 0; b < 2; ++b)
#pragma unroll
                for (int m = 0; m < 4; ++m)
#pragma unroll
                    for (int n = 0; n < 2; ++n) acc[a][b][m][n] = (f32x4){0.f, 0.f, 0.f, 0.f};
        cur = nxt; cA = nA; cB = nB; ++ui;
        if constexpr (ALIGN_EPI) { if (wr == 1) PG8_BAR; }
    }
    PG8_WAIT_V(0);
    if constexpr (!ALIGN_EPI) { if (wr == 0) PG8_BAR; }
    PG8_BAR;
    if constexpr (Epi::AFTER_DRAIN) { E.fused(acc, cur, wr, wc, fr, fq, lds, wid, lane); S.done(cur); }
#undef PG8_SA
#undef PG8_SB
#undef PG8_STAGE
#undef PG8_LDA
#undef PG8_LDB
#undef PG8_MMA
#undef PG8_WAIT_V
#undef PG8_WAIT_L
#undef PG8_BAR
#undef PG8_SCHED
}
}

#include <hip/hip_cooperative_groups.h>
namespace cg = cooperative_groups;
#define LAS __attribute__((address_space(3)))
typedef unsigned short bf16_t;
typedef short bf16x8 __attribute__((ext_vector_type(8)));
typedef short s16x4 __attribute__((ext_vector_type(4)));
typedef float f32x4 __attribute__((ext_vector_type(4)));
typedef float f32x16 __attribute__((ext_vector_type(16)));
typedef unsigned u32x4 __attribute__((ext_vector_type(4)));
typedef unsigned u32x2 __attribute__((ext_vector_type(2)));
using pg8::bf2f; using pg8::bflo; using pg8::bfhi; using pg8::silu_f; using pg8::gelu_tanh_f; using pg8::cvt_pk_bf16;

constexpr int MROWS = 16384, SEQL = 4096, DM = 2048;
constexpr size_t MiB = 1u << 20;
constexpr size_t WS_ROPE = 1 * MiB;
constexpr size_t WS_AT = WS_ROPE + 512 * 1024;
constexpr size_t WS_S5 = 2 * MiB;
constexpr size_t WS_W = 34 * MiB;
constexpr size_t W_INE = 0, W_GLU = 20 * MiB, W_OUTE = 22 * MiB, W_INO = 30 * MiB, W_OUTO = 62 * MiB, W_PER = 70 * MiB;
constexpr size_t WS_XN = 174 * MiB;
constexpr size_t WS_PROJ = 238 * MiB;
constexpr size_t WS_YAP = WS_PROJ + 160 * MiB;
constexpr size_t WS_END = 494 * MiB;
constexpr int SUBLN_OFF = 147456;
constexpr int LDS_BYTES = 147456 + 1024 + 256;

__device__ __forceinline__ float wave_sum(float v) {
#pragma unroll
    for (int o = 1; o < 64; o <<= 1) v += __shfl_xor(v, o);
    return v;
}
__device__ __forceinline__ f32x16 mfma32(bf16x8 a, bf16x8 b, f32x16 c) { return __builtin_amdgcn_mfma_f32_32x32x16_bf16(a, b, c, 0, 0, 0); }
__device__ __forceinline__ s16x4 lds_tr(const LAS unsigned char* p) {
    return __builtin_bit_cast(s16x4, __builtin_amdgcn_ds_read_tr16_b64_v4i16((LAS s16x4*)p));
}
__device__ __forceinline__ bf16x8 pack8(const float* v) {
    u32x4 w; w.x = cvt_pk_bf16(v[0], v[1]); w.y = cvt_pk_bf16(v[2], v[3]); w.z = cvt_pk_bf16(v[4], v[5]); w.w = cvt_pk_bf16(v[6], v[7]);
    return __builtin_bit_cast(bf16x8, w);
}
__device__ __forceinline__ void sincos_red(double x, float& s, float& c) {
    const double k = rint(x * 0.15915494309189535);
    const float r = (float)(x - k * 6.283185307179586);
    s = __sinf(r); c = __cosf(r);
}

__device__ __forceinline__ void transpose_item(const float* __restrict__ W, int K, int N, bf16_t* __restrict__ WT, float* scr, int item, int lane, const float* gk = nullptr) {
    const int nblk = N / 32, kb = item / nblk, nb = item % nblk, k0 = 64 * kb, n0 = 32 * nb;
    f32x4 v[8];
#pragma unroll
    for (int i = 0; i < 8; ++i) { v[i] = *(const f32x4*)(W + (size_t)(k0 + 8 * i + (lane >> 3)) * N + n0 + 4 * (lane & 7)); if (gk) v[i] = v[i] * gk[k0 + 8 * i + (lane >> 3)]; }
#pragma unroll
    for (int i = 0; i < 8; ++i) { float* d = scr + (8 * i + (lane >> 3)) * 33 + 4 * (lane & 7); d[0] = v[i][0]; d[1] = v[i][1]; d[2] = v[i][2]; d[3] = v[i][3]; }
    asm volatile("s_waitcnt lgkmcnt(0)" ::: "memory");
    const int c = lane & 7;
#pragma unroll
    for (int j = 0; j < 4; ++j) { const int n = (lane >> 3) + 8 * j; const float* s = scr + (8 * c) * 33 + n;
        u32x4 o; o.x = cvt_pk_bf16(s[0 * 33], s[1 * 33]); o.y = cvt_pk_bf16(s[2 * 33], s[3 * 33]); o.z = cvt_pk_bf16(s[4 * 33], s[5 * 33]); o.w = cvt_pk_bf16(s[6 * 33], s[7 * 33]);
        *(u32x4*)(WT + (size_t)(n0 + n) * K + k0 + 8 * c) = o; }
    asm volatile("s_waitcnt lgkmcnt(0)" ::: "memory");
}
__device__ __forceinline__ void transpose_block(const float* __restrict__ W, int K, int N, bf16_t* __restrict__ WT, float* scr, int item, int tid, const float* gk) {
    const int nblk = N / 256, kb = item / nblk, nb = item % nblk, k0 = 64 * kb, n0 = 256 * nb;
    f32x4 v[8];
#pragma unroll
    for (int i = 0; i < 8; ++i) { const int idx = tid + 512 * i, row = idx >> 6, c4 = idx & 63; v[i] = *(const f32x4*)(W + (size_t)(k0 + row) * N + n0 + 4 * c4); if (gk) v[i] = v[i] * gk[k0 + row]; }
#pragma unroll
    for (int i = 0; i < 8; ++i) { const int idx = tid + 512 * i, row = idx >> 6, c4 = idx & 63; float* d = scr + row * 257 + 4 * c4; d[0] = v[i][0]; d[1] = v[i][1]; d[2] = v[i][2]; d[3] = v[i][3]; }
    __syncthreads();
#pragma unroll
    for (int j = 0; j < 4; ++j) { const int idx = tid + 512 * j, n = idx >> 3, c = idx & 7; const float* sp = scr + (8 * c) * 257 + n;
        u32x4 o; o.x = cvt_pk_bf16(sp[0 * 257], sp[1 * 257]); o.y = cvt_pk_bf16(sp[2 * 257], sp[3 * 257]); o.z = cvt_pk_bf16(sp[4 * 257], sp[5 * 257]); o.w = cvt_pk_bf16(sp[6 * 257], sp[7 * 257]);
        *(u32x4*)(WT + (size_t)(n0 + n) * K + k0 + 8 * c) = o; }
    __syncthreads();
}

template <bool FINAL> __device__ __forceinline__ void rms_row(const float* xrow, const float* g, bf16_t* obf, float* of32, int lane) {
    const f32x4* xr = (const f32x4*)xrow + lane; const f32x4* gr = (const f32x4*)g + lane;
    f32x4 v[8], gg[8]; float s = 0.f;
#pragma unroll
    for (int j = 0; j < 8; ++j) { v[j] = xr[64 * j]; gg[j] = gr[64 * j]; }
#pragma unroll
    for (int j = 0; j < 8; ++j) s += (v[j].x * v[j].x + v[j].y * v[j].y) + (v[j].z * v[j].z + v[j].w * v[j].w);
    const float rstd = rsqrtf(wave_sum(s) * (1.f / 2048.f) + 1e-6f);
#pragma unroll
    for (int j = 0; j < 8; ++j) { const f32x4 o = v[j] * rstd * gg[j];
        if (FINAL) ((f32x4*)of32)[64 * j + lane] = o;
        else { u32x2 w; w.x = cvt_pk_bf16(o.x, o.y); w.y = cvt_pk_bf16(o.z, o.w); ((u32x2*)obf)[64 * j + lane] = w; } }
}
__device__ __forceinline__ void rms_rows4_final(float* x, int m0, int step, const float* g, int lane) {
    f32x4 v[4][8], gg[8]; float s[4];
#pragma unroll
    for (int r = 0; r < 4; ++r)
#pragma unroll
        for (int j = 0; j < 8; ++j) v[r][j] = ((const f32x4*)(x + (size_t)(m0 + r * step) * DM))[64 * j + lane];
#pragma unroll
    for (int j = 0; j < 8; ++j) gg[j] = ((const f32x4*)g)[64 * j + lane];
#pragma unroll
    for (int r = 0; r < 4; ++r) { float a = 0.f;
#pragma unroll
        for (int j = 0; j < 8; ++j) a += (v[r][j].x * v[r][j].x + v[r][j].y * v[r][j].y) + (v[r][j].z * v[r][j].z + v[r][j].w * v[r][j].w);
        s[r] = a; }
#pragma unroll
    for (int o = 1; o < 64; o <<= 1)
#pragma unroll
        for (int r = 0; r < 4; ++r) s[r] += __shfl_xor(s[r], o);
#pragma unroll
    for (int r = 0; r < 4; ++r) { const float rstd = rsqrtf(s[r] * (1.f / 2048.f) + 1e-6f);
#pragma unroll
        for (int j = 0; j < 8; ++j) ((f32x4*)(x + (size_t)(m0 + r * step) * DM))[64 * j + lane] = v[r][j] * rstd * gg[j]; }
}

__device__ __forceinline__ void xb_row(const float* xrow, bf16_t* obf, float* ssq, int lane) {
    const f32x4* xr = (const f32x4*)xrow + lane; float s = 0.f;
    f32x4 v[8];
#pragma unroll
    for (int j = 0; j < 8; ++j) v[j] = xr[64 * j];
#pragma unroll
    for (int j = 0; j < 8; ++j) { s += (v[j].x * v[j].x + v[j].y * v[j].y) + (v[j].z * v[j].z + v[j].w * v[j].w);
        u32x2 w; w.x = cvt_pk_bf16(v[j].x, v[j].y); w.y = cvt_pk_bf16(v[j].z, v[j].w); ((u32x2*)obf)[64 * j + lane] = w; }
    s = wave_sum(s);
    if (lane == 0) *ssq = s;
}

__device__ __forceinline__ void xb_rows4(const float* x, bf16_t* xb, float* ssq, int m0, int step, int lane) {
    f32x4 v[4][8]; float s[4];
#pragma unroll
    for (int r = 0; r < 4; ++r)
#pragma unroll
        for (int j = 0; j < 8; ++j) v[r][j] = ((const f32x4*)(x + (size_t)(m0 + r * step) * DM))[64 * j + lane];
#pragma unroll
    for (int r = 0; r < 4; ++r) { float a = 0.f;
#pragma unroll
        for (int j = 0; j < 8; ++j) { a += (v[r][j].x * v[r][j].x + v[r][j].y * v[r][j].y) + (v[r][j].z * v[r][j].z + v[r][j].w * v[r][j].w);
            u32x2 w; w.x = cvt_pk_bf16(v[r][j].x, v[r][j].y); w.y = cvt_pk_bf16(v[r][j].z, v[r][j].w); ((u32x2*)(xb + (size_t)(m0 + r * step) * DM))[64 * j + lane] = w; }
        s[r] = a; }
#pragma unroll
    for (int o = 1; o < 64; o <<= 1)
#pragma unroll
        for (int r = 0; r < 4; ++r) s[r] += __shfl_xor(s[r], o);
    if (lane == 0) {
#pragma unroll
        for (int r = 0; r < 4; ++r) ssq[m0 + r * step] = s[r]; }
}

__device__ __forceinline__ void s5_tables(int jl, int g, const float* lam_re, const float* lam_im, const float* log_dt, const float* b_re, const float* b_im,
                                          const float* c_re, const float* c_im, const float* d_skip, unsigned char* ws, float* L, int tid) {
    float* are = L;
    float* aim = L + 1088;
    float* bbr = L + 2176;
    float* bbi = L + 3200;
    float* cr = L + 4224;
    float* ci = L + 5248;
    float* Kl = L + 6272;
    float* fre = L + 10368;
    float* fim = L + 10432;
    const int combo = jl * 64 + g;
    if (tid < 64) {
        const int p = tid;
        const float dt = expf(log_dt[combo]); const float lr = lam_re[combo * 64 + p], li = lam_im[combo * 64 + p];
        const double xr = (double)lr * (double)dt, xi = (double)li * (double)dt;
        for (int t = 0; t <= 16; ++t) { float s, c; sincos_red(xi * t, s, c); const float mag = expf((float)(xr * t)); are[t * 64 + p] = mag * c; aim[t * 64 + p] = mag * s; }
        float s1, c1, sh, chh; sincos_red(xi, s1, c1); sincos_red(xi * 0.5, sh, chh);
        const float em1 = expm1f((float)xr); const float mag1 = em1 + 1.f;
        const float nr = em1 * c1 - 2.f * sh * sh, abi = mag1 * s1;
        const float den = lr * lr + li * li;
        fre[p] = (nr * lr + abi * li) / den; fim[p] = (abi * lr - nr * li) / den;
    }
    __syncthreads();
    for (int i = tid; i < 1024; i += 512) {
        const int p = i >> 4; const float br = b_re[combo * 1024 + i], bi = b_im[combo * 1024 + i];
        bbr[i] = fre[p] * br - fim[p] * bi; bbi[i] = fre[p] * bi + fim[p] * br;
        cr[i] = c_re[combo * 1024 + i]; ci[i] = c_im[combo * 1024 + i];
    }
    __syncthreads();
    {
        const int th = tid >> 1, tau = th >> 4, h = th & 15, hb = (tid & 1) * 8;
        float k[8];
#pragma unroll
        for (int e = 0; e < 8; ++e) k[e] = 0.f;
        for (int p = 0; p < 64; ++p) {
            const float c_r = cr[h * 64 + p], c_i = ci[h * 64 + p], a_r = are[tau * 64 + p], a_i = aim[tau * 64 + p];
            const float gr = c_r * a_r - c_i * a_i, gi = c_r * a_i + c_i * a_r;
#pragma unroll
            for (int e = 0; e < 8; ++e) k[e] += gr * bbr[p * 16 + hb + e] - gi * bbi[p * 16 + hb + e];
        }
#pragma unroll
        for (int e = 0; e < 8; ++e) { float v = k[e]; if (tau == 0 && h == hb + e) v += d_skip[jl * 1024 + g * 16 + h]; Kl[tau * 256 + h * 16 + hb + e] = v; }
    }
    __syncthreads();
    unsigned* Kt = (unsigned*)(ws + WS_S5 + (size_t)combo * 262144);
    unsigned* E = Kt + 32768; unsigned* F = E + 16384;
    for (int i = tid; i < 32768; i += 512) {
        const int o = i >> 7, k = (i & 127) * 2, t = o >> 4, h = o & 15, s = k >> 4, hp = k & 15;
        float v0 = 0.f, v1 = 0.f;
        if (s <= t) { v0 = Kl[(t - s) * 256 + h * 16 + hp]; v1 = Kl[(t - s) * 256 + h * 16 + hp + 1]; }
        Kt[i] = cvt_pk_bf16(v0, v1);
    }
    for (int i = tid; i < 16384; i += 512) {
        const int e = i >> 7, k = (i & 127) * 2, s = k >> 4, hp = k & 15, p = e & 63;
        const float a_r = are[(15 - s) * 64 + p], a_i = aim[(15 - s) * 64 + p];
        float v0, v1;
        if (e < 64) { v0 = a_r * bbr[p * 16 + hp] - a_i * bbi[p * 16 + hp]; v1 = a_r * bbr[p * 16 + hp + 1] - a_i * bbi[p * 16 + hp + 1]; }
        else { v0 = a_r * bbi[p * 16 + hp] + a_i * bbr[p * 16 + hp]; v1 = a_r * bbi[p * 16 + hp + 1] + a_i * bbr[p * 16 + hp + 1]; }
        E[i] = cvt_pk_bf16(v0, v1);
    }
    for (int i = tid; i < 16384; i += 512) {
        const int o = i >> 6, e = (i & 63) * 2, t = o >> 4, h = o & 15;
        float v[2];
#pragma unroll
        for (int q = 0; q < 2; ++q) { const int ee = e + q, p = ee & 63; const float c_r = cr[h * 64 + p], c_i = ci[h * 64 + p], a_r = are[(t + 1) * 64 + p], a_i = aim[(t + 1) * 64 + p];
            v[q] = (ee < 64) ? (c_r * a_r - c_i * a_i) : -(c_r * a_i + c_i * a_r); }
        F[i] = cvt_pk_bf16(v[0], v[1]);
    }
    float* AT = (float*)(ws + WS_AT) + combo * 128;
    if (tid < 64) { AT[tid] = are[16 * 64 + tid]; AT[64 + tid] = aim[16 * 64 + tid]; }
    __syncthreads();
}

__device__ __forceinline__ void s5_item(int b, int g, const unsigned char* tab, const float* AT, const bf16_t* proj, bf16_t* yap, unsigned char* lds, int tid) {
    const int w = __builtin_amdgcn_readfirstlane(tid >> 6);
    constexpr int ZS = 132;
#define RELANE() int tl_ = tid; asm volatile("" : "+v"(tl_)); const int lane = tl_ & 63, n32 = lane & 31, hl = lane >> 5; (void)lane; (void)n32; (void)hl;
    float* Z = (float*)lds;
    const bf16_t* Kt = (const bf16_t*)tab; const bf16_t* E = Kt + 65536; const bf16_t* F = E + 32768;
    bf16x8 uf[16];
    { RELANE();
    const size_t rowbase = (size_t)b * SEQL + 16 * (32 * w + n32);
#pragma unroll
    for (int s = 0; s < 16; ++s) uf[s] = *(const bf16x8*)(proj + ((size_t)(b * 64 + g) * 4096 + 16 * (32 * w + n32) + s) * 16 + 8 * hl);
    }
#pragma unroll
    for (int eb = 0; eb < 4; ++eb) {
        RELANE();
        f32x16 acc;
#pragma unroll
        for (int r = 0; r < 16; ++r) acc[r] = 0.f;
#pragma unroll
        for (int sb = 0; sb < 2; ++sb) {
            bf16x8 bq[8];
#pragma unroll
            for (int i = 0; i < 8; ++i) bq[i] = *(const bf16x8*)(E + (32 * eb + n32) * 256 + 16 * (8 * sb + i) + 8 * hl);
            __builtin_amdgcn_sched_barrier(0);
#pragma unroll
            for (int i = 0; i < 8; ++i) acc = mfma32(uf[8 * sb + i], bq[i], acc);
            __builtin_amdgcn_sched_barrier(0);
        }
#pragma unroll
        for (int r = 0; r < 16; ++r) { const int c = (r & 3) + 8 * (r >> 2) + 4 * hl; Z[(32 * w + c) * ZS + 32 * eb + n32] = acc[r]; }
    }
    __syncthreads();
    if (w == 0) {
        RELANE();
        const float ar = AT[lane], ai = AT[64 + lane]; float sr = 0.f, si = 0.f;
#pragma unroll 8
        for (int c = 0; c < 256; ++c) { const float zr = Z[c * ZS + lane], zi = Z[c * ZS + 64 + lane]; Z[c * ZS + lane] = sr; Z[c * ZS + 64 + lane] = si;
            const float nr = ar * sr - ai * si + zr, ni = ar * si + ai * sr + zi; sr = nr; si = ni; }
    }
    __syncthreads();
    bf16x8 sf[8];
#pragma unroll
    for (int s = 0; s < 8; ++s) { RELANE(); const float* zp = Z + (32 * w + n32) * ZS + 16 * s + 8 * hl; const f32x4 a = *(const f32x4*)zp, bq = *(const f32x4*)(zp + 4);
        float t8[8] = {a[0], a[1], a[2], a[3], bq[0], bq[1], bq[2], bq[3]}; sf[s] = pack8(t8); }
#pragma unroll
    for (int ob = 0; ob < 8; ++ob) {
        RELANE();
        f32x16 acc;
#pragma unroll
        for (int r = 0; r < 16; ++r) acc[r] = 0.f;
        {
            const int nk = 2 * ob + 2, total = nk + 8;
#define S5_LDB(i) (((i) < nk) ? *(const bf16x8*)(Kt + (32 * ob + n32) * 256 + 16 * (i) + 8 * hl) : *(const bf16x8*)(F + (32 * ob + n32) * 128 + 16 * ((i) - nk) + 8 * hl))
#define S5_AFR(i) (((i) < nk) ? uf[(i) < nk ? (i) : 0] : sf[(i) < nk ? 0 : (i) - nk])
            bf16x8 cur[8], nxt[8];
#pragma unroll
            for (int i = 0; i < 8; ++i) cur[i] = S5_LDB(i);
#pragma unroll
            for (int b0 = 0; b0 < total; b0 += 8) {
#pragma unroll
                for (int i = 0; i < 8; ++i) nxt[i] = (b0 + 8 + i < total) ? S5_LDB(b0 + 8 + i) : cur[i];
                __builtin_amdgcn_sched_barrier(0);
#pragma unroll
                for (int i = 0; i < 8; ++i) if (b0 + i < total) acc = mfma32(S5_AFR(b0 + i), cur[i], acc);
                __builtin_amdgcn_sched_barrier(0);
#pragma unroll
                for (int i = 0; i < 8; ++i) cur[i] = nxt[i];
            }
#undef S5_LDB
#undef S5_AFR
        }
        const int t = 2 * ob + (n32 >> 4), hh = n32 & 15;
#pragma unroll
        for (int r = 0; r < 16; ++r) { const int c = (r & 3) + 8 * (r >> 2) + 4 * hl; const size_t pos = (size_t)b * SEQL + 16 * (32 * w + c) + t;
            yap[pos * 1024 + g * 16 + hh] = (bf16_t)(cvt_pk_bf16(gelu_tanh_f(acc[r]), 0.f) & 0xffffu); }
        asm volatile("" ::: "memory");
    }
    __syncthreads();
#undef RELANE
}

__device__ __forceinline__ void sgu_item(int b, int nc, int gh, const bf16_t* proj, bf16_t* mix, const float* ln_g, const float* ln_b, const bf16_t* wspb  , const float* b_sp,
                                         unsigned char* lds, int tid) {
    const int w = __builtin_amdgcn_readfirstlane(tid >> 6);
#define RELANE() int tl_ = tid; asm volatile("" : "+v"(tl_)); const int lane = tl_ & 63, n32 = lane & 31, hl = lane >> 5; (void)lane; (void)n32; (void)hl;
    float* stat = (float*)lds; unsigned char* Vn = lds + 1024; constexpr int VS = 320;
    const size_t row0 = (size_t)b * SEQL + nc * 128;
#pragma unroll
    for (int hb = 0; hb < 2; ++hb) {
        RELANE();
        u32x4 a[8], c[8];
#pragma unroll
        for (int i = 0; i < 8; ++i) { const bf16_t* vp = proj + (row0 + 16 * w + 8 * hb + i) * 5120 + 3072 + lane * 16; a[i] = *(const u32x4*)vp; c[i] = *(const u32x4*)(vp + 8); }
        float sm[8], sq[8];
#pragma unroll
        for (int i = 0; i < 8; ++i) {
            const float x[16] = {bflo(a[i].x), bfhi(a[i].x), bflo(a[i].y), bfhi(a[i].y), bflo(a[i].z), bfhi(a[i].z), bflo(a[i].w), bfhi(a[i].w), bflo(c[i].x), bfhi(c[i].x), bflo(c[i].y), bfhi(c[i].y), bflo(c[i].z), bfhi(c[i].z), bflo(c[i].w), bfhi(c[i].w)};
            float s1 = 0.f, s2 = 0.f;
#pragma unroll
            for (int e = 0; e < 16; ++e) { s1 += x[e]; s2 += x[e] * x[e]; }
            sm[i] = s1; sq[i] = s2;
        }
#pragma unroll
        for (int o = 1; o < 64; o <<= 1)
#pragma unroll
            for (int i = 0; i < 8; ++i) { sm[i] += __shfl_xor(sm[i], o); sq[i] += __shfl_xor(sq[i], o); }
#pragma unroll
        for (int i = 0; i < 8; ++i) { const float mean = sm[i] * (1.f / 1024.f); const float var = fmaxf(sq[i] * (1.f / 1024.f) - mean * mean, 0.f);
            if (lane == 0) { const int s = 16 * w + 8 * hb + i; stat[2 * s] = mean; stat[2 * s + 1] = rsqrtf(var + 1e-5f); } }
    }
    __syncthreads();
    for (int gi = 0; gi < 4; ++gi) {
        const int g = 4 * gh + gi;
        const int tb = w >> 1, cb0 = 2 * (w & 1);
        bf16x8 afr[8];
        {
            RELANE();
            const bf16_t* wp = wspb + ((size_t)g * 128 + 32 * tb + n32) * 128 + 8 * hl;
#pragma unroll
            for (int ks = 0; ks < 8; ++ks) afr[ks] = *(const bf16x8*)(wp + 16 * ks);
            const int ch = tl_ & 15, sb = tl_ >> 4;
            u32x4 av[4];
#pragma unroll
            for (int i = 0; i < 4; ++i) av[i] = *(const u32x4*)(proj + (row0 + sb + 32 * i) * 5120 + 3072 + g * 128 + 8 * ch);
            const f32x4 g0 = *(const f32x4*)(ln_g + g * 128 + 8 * ch), g1 = *(const f32x4*)(ln_g + g * 128 + 8 * ch + 4);
            const f32x4 b0 = *(const f32x4*)(ln_b + g * 128 + 8 * ch), b1 = *(const f32x4*)(ln_b + g * 128 + 8 * ch + 4);
#pragma unroll
            for (int i = 0; i < 4; ++i) {
                const int s = sb + 32 * i; const u32x4 a = av[i];
                const float mean = stat[2 * s], rstd = stat[2 * s + 1];
                float o[8];
                o[0] = (bflo(a.x) - mean) * rstd * g0[0] + b0[0]; o[1] = (bfhi(a.x) - mean) * rstd * g0[1] + b0[1];
                o[2] = (bflo(a.y) - mean) * rstd * g0[2] + b0[2]; o[3] = (bfhi(a.y) - mean) * rstd * g0[3] + b0[3];
                o[4] = (bflo(a.z) - mean) * rstd * g1[0] + b1[0]; o[5] = (bfhi(a.z) - mean) * rstd * g1[1] + b1[1];
                o[6] = (bflo(a.w) - mean) * rstd * g1[2] + b1[2]; o[7] = (bfhi(a.w) - mean) * rstd * g1[3] + b1[3];
                *(bf16x8*)(Vn + s * VS + ch * 16) = pack8(o);
            }
        }
        __syncthreads();
        f32x16 acc0, acc1;
#pragma unroll
        for (int r = 0; r < 16; ++r) { acc0[r] = 0.f; acc1[r] = 0.f; }
        {
            RELANE();
            const int q4 = (lane & 15) >> 2, p4 = lane & 3, cpart = 16 * ((lane >> 4) & 1) + 4 * p4;
#pragma unroll
            for (int ks = 0; ks < 8; ++ks) {
                if (ks >= 2 * tb + 2) continue;
                const LAS unsigned char* vb = (const LAS unsigned char*)Vn + (16 * ks + 8 * hl + q4) * VS + cpart * 2;
                const s16x4 l0 = lds_tr(vb + (32 * cb0) * 2), h0 = lds_tr(vb + 4 * VS + (32 * cb0) * 2);
                const s16x4 l1 = lds_tr(vb + (32 * cb0 + 32) * 2), h1 = lds_tr(vb + 4 * VS + (32 * cb0 + 32) * 2);
                const bf16x8 bf0 = {l0[0], l0[1], l0[2], l0[3], h0[0], h0[1], h0[2], h0[3]};
                const bf16x8 bf1 = {l1[0], l1[1], l1[2], l1[3], h1[0], h1[1], h1[2], h1[3]};
                acc0 = mfma32(afr[ks], bf0, acc0); acc1 = mfma32(afr[ks], bf1, acc1);
            }
        }
        {
            float* So = (float*)(lds + 1024 + 128 * VS);
#pragma unroll
            for (int cc = 0; cc < 2; ++cc) {
                RELANE();
                const int c = 32 * (cb0 + cc) + n32;
#pragma unroll
                for (int r = 0; r < 16; ++r) { const int t = 32 * tb + (r & 3) + 8 * (r >> 2) + 4 * hl;
                    So[t * 132 + c] = (cc == 0 ? acc0[r] : acc1[r]) + b_sp[g * 128 + t]; }
            }
            __syncthreads();
            {
                RELANE();
                const int ch = tl_ & 15, tbs = tl_ >> 4;
                u32x4 u8[4], g8[4];
#pragma unroll
                for (int i = 0; i < 4; ++i) { const size_t row = row0 + tbs + 32 * i;
                    u8[i] = *(const u32x4*)(proj + row * 5120 + 2048 + g * 128 + 8 * ch); g8[i] = *(const u32x4*)(proj + row * 5120 + 4096 + g * 128 + 8 * ch); }
#pragma unroll
                for (int i = 0; i < 4; ++i) {
                    const int t = tbs + 32 * i; const size_t row = row0 + t;
                    const f32x4 s0 = *(const f32x4*)(So + t * 132 + 8 * ch), s1 = *(const f32x4*)(So + t * 132 + 8 * ch + 4);
                    u32x4 o;
                    o.x = cvt_pk_bf16(bflo(u8[i].x) * s0[0] * bflo(g8[i].x), bfhi(u8[i].x) * s0[1] * bfhi(g8[i].x));
                    o.y = cvt_pk_bf16(bflo(u8[i].y) * s0[2] * bflo(g8[i].y), bfhi(u8[i].y) * s0[3] * bfhi(g8[i].y));
                    o.z = cvt_pk_bf16(bflo(u8[i].z) * s1[0] * bflo(g8[i].z), bfhi(u8[i].z) * s1[1] * bfhi(g8[i].z));
                    o.w = cvt_pk_bf16(bflo(u8[i].w) * s1[2] * bflo(g8[i].w), bfhi(u8[i].w) * s1[3] * bfhi(g8[i].w));
                    *(u32x4*)((bf16_t*)proj + row * 5120 + 2048 + g * 128 + 8 * ch) = o;
                }
            }
        }
        __syncthreads();
    }
#undef RELANE
}

constexpr int AK_BYTES = 16384, AV_BYTES = 32768, AV_OFF = 3 * AK_BYTES;
__device__ __forceinline__ void glds16(const void* gsrc, unsigned lds_dst) {
    unsigned keep;
    asm volatile("s_mov_b32 %0, m0\n\ts_mov_b32 m0, %2\n\ts_nop 0\n\tglobal_load_lds_dwordx4 %1, off\n\ts_mov_b32 m0, %0" : "=&s"(keep) : "v"(gsrc), "s"(lds_dst) : "memory");
}
struct DmaOff { unsigned k[2], v[4]; };
__device__ __forceinline__ DmaOff attn_dma_off(int w, int tl) {
    DmaOff o; const int lane = tl & 63;
#pragma unroll
    for (int i = 0; i < 2; ++i) { const int key = 8 * w + 4 * i + (lane >> 4), c = (lane & 15) ^ (key & 15); o.k[i] = (unsigned)key * 16384u + (unsigned)c * 16u; }
#pragma unroll
    for (int i = 0; i < 4; ++i) { const int key = 8 * w + 2 * i + (lane >> 5), c = (lane & 31) ^ ((key & 3) << 2); o.v[i] = (unsigned)key * 16384u + (unsigned)c * 16u; }
    return o;
}
__device__ __forceinline__ void attn_dma(const char* kb_t, const char* vb_t, unsigned char* lds, int bb, int w, const DmaOff& o) {
    const unsigned l0 = (unsigned)(uintptr_t)lds;
#pragma unroll
    for (int i = 0; i < 2; ++i) glds16(kb_t + (size_t)o.k[i], (unsigned)__builtin_amdgcn_readfirstlane(l0 + bb * AK_BYTES + (2 * w + i) * 1024));
#pragma unroll
    for (int i = 0; i < 4; ++i) glds16(vb_t + (size_t)o.v[i], (unsigned)__builtin_amdgcn_readfirstlane(l0 + AV_OFF + bb * AV_BYTES + (4 * w + i) * 1024));
}
__device__ __forceinline__ void attn_unit(int b, int h, int qblk, const bf16_t* proj, bf16_t* mix, float lam, const float* subln, float oscale, unsigned char* lds, int tid_in) {
    const int w = __builtin_amdgcn_readfirstlane(tid_in >> 6);
    const int q0 = qblk * 256;
    const int NT = 4 * qblk + 4;
    const int wq_lo = q0 + 32 * w, wq_hi = wq_lo + 31;
    f32x16 O[8];
#pragma unroll
    for (int j = 0; j < 2; ++j) {
        __builtin_amdgcn_sched_barrier(0);
        bf16x8 qf[8]; DmaOff dmo; int kofs[8];
        const char* kbase = (const char*)(proj + (size_t)b * SEQL * 8192 + 2048 + h * 256 + j * 128);
        const char* vbase = (const char*)(proj + (size_t)b * SEQL * 8192 + 4096 + h * 256);
        {
            int tl = tid_in; asm volatile("" : "+v"(tl));
            dmo = attn_dma_off(w, tl);
            attn_dma(kbase, vbase, lds, 0, w, dmo);
            attn_dma(kbase + (size_t)64 * 16384, vbase + (size_t)64 * 16384, lds, 1, w, dmo);
            { const int n32_ = tl & 31, hl_ = (tl >> 5) & 1; const int u4_ = (hl_ ^ (n32_ & 15)) << 4;
#pragma unroll
              for (int i = 0; i < 8; ++i) kofs[i] = n32_ * 256 + ((i * 32) ^ u4_); }
            const int lane = tl & 63, n32 = lane & 31, hl = lane >> 5;
            const size_t grow = (size_t)b * SEQL + q0 + 32 * w + n32;
#pragma unroll
            for (int d0 = 0; d0 < 8; ++d0) qf[d0] = *(const bf16x8*)(proj + grow * 8192 + h * 256 + j * 128 + 16 * d0 + 8 * hl);
        }
#pragma unroll
        for (int vb = 0; vb < 8; ++vb)
#pragma unroll
            for (int r = 0; r < 16; ++r) O[vb][r] = 0.f;
        float mrun = -1e30f, lrun = 0.f;
#pragma unroll
        for (int d0 = 0; d0 < 8; ++d0) asm volatile("" : "+v"(qf[d0]));
        asm volatile("s_waitcnt vmcnt(0)" ::: "memory");
        __syncthreads();
        int bb = 0;
        for (int t = 0; t < NT; ++t) {
            int tid = tid_in; asm volatile("" : "+v"(tid));
            const int b2 = (bb == 0) ? 2 : bb - 1;
            if (t + 2 < NT) attn_dma(kbase + (size_t)(t + 2) * 64 * 16384, vbase + (size_t)(t + 2) * 64 * 16384, lds, b2, w, dmo);
            if (64 * t <= wq_hi) {
                const int lane = tid & 63, n32 = lane & 31, hl = lane >> 5;
                const int q4 = (lane & 15) >> 2, cpart = 16 * ((lane >> 4) & 1) + 4 * (lane & 3);
                const int qrow = q0 + 32 * w + n32;
                const LAS unsigned char* Kb = (const LAS unsigned char*)lds + bb * AK_BYTES;
                const int u4 = (hl ^ (n32 & 15)) << 4;
                const LAS unsigned char* Vb = (const LAS unsigned char*)lds + AV_OFF + bb * AV_BYTES + (4 * hl + q4) * 512 + 2 * cpart;
                const int vs0 = (0 ^ q4) << 6, vs1 = (1 ^ q4) << 6, vs2 = (2 ^ q4) << 6, vs3 = (3 ^ q4) << 6;
#pragma unroll
                for (int sub = 0; sub < 2; ++sub) {
                    if (64 * t + 32 * sub <= wq_hi) {
                        f32x16 S;
#pragma unroll
                        for (int r = 0; r < 16; ++r) S[r] = 0.f;
#pragma unroll
                        for (int dg = 0; dg < 2; ++dg) {
                            bf16x8 ka[4];
#pragma unroll
                            for (int i = 0; i < 4; ++i) ka[i] = *(const LAS bf16x8*)(Kb + sub * 8192 + kofs[4 * dg + i]);
#pragma unroll
                            for (int i = 0; i < 4; ++i) S = mfma32(ka[i], qf[4 * dg + i], S);
                        }
                        if (64 * t + 32 * sub + 31 > wq_lo) {
#pragma unroll
                            for (int r = 0; r < 16; ++r) { const int kidx = 64 * t + 32 * sub + (r & 3) + 8 * (r >> 2) + 4 * hl; if (kidx > qrow) S[r] = -INFINITY; }
                        }
                        float mx = fmaxf(S[0], S[1]);
#pragma unroll
                        for (int r = 2; r < 16; ++r) mx = fmaxf(mx, S[r]);
                        mx = fmaxf(mx, __shfl_xor(mx, 32));
                        if (__any(mx > mrun + 8.f)) {
                            const float mnew = fmaxf(mrun, mx); const float alpha = __builtin_amdgcn_exp2f(mrun - mnew);
                            lrun *= alpha; mrun = mnew;
#pragma unroll
                            for (int vb = 0; vb < 8; ++vb)
#pragma unroll
                                for (int r = 0; r < 16; ++r) O[vb][r] *= alpha;
                        }
                        float ls = 0.f;
#pragma unroll
                        for (int r = 0; r < 16; ++r) { S[r] = __builtin_amdgcn_exp2f(S[r] - mrun); ls += S[r]; }
                        lrun += ls;
                        bf16x8 pf[2];
                        { float t8[8];
#pragma unroll
                          for (int s = 0; s < 2; ++s) {
#pragma unroll
                              for (int e = 0; e < 8; ++e) t8[e] = S[8 * s + e];
                              pf[s] = pack8(t8); } }
                        {
                            const LAS unsigned char* vrow = Vb + (32 * sub) * 512;
#define VLD(dst, g_) do { _Pragma("unroll") for (int i_ = 0; i_ < 4; ++i_) { const int s_ = (g_) >> 1, vb_ = 4 * ((g_) & 1) + i_; \
        const int vs_ = (i_ == 0) ? vs0 : (i_ == 1) ? vs1 : (i_ == 2) ? vs2 : vs3; \
        dst[2 * i_] = lds_tr(vrow + s_ * 16 * 512 + vs_ + (vb_ >> 2) * 256); dst[2 * i_ + 1] = lds_tr(vrow + s_ * 16 * 512 + vs_ + (vb_ >> 2) * 256 + 8 * 512); } } while (0)
                            s16x4 cur[8];
                            __builtin_amdgcn_sched_barrier(0);
#pragma unroll
                            for (int g = 0; g < 4; ++g) {
                                VLD(cur, g);
#pragma unroll
                                for (int i = 0; i < 4; ++i) { const int vb = 4 * (g & 1) + i;
                                    const bf16x8 af = {cur[2 * i][0], cur[2 * i][1], cur[2 * i][2], cur[2 * i][3], cur[2 * i + 1][0], cur[2 * i + 1][1], cur[2 * i + 1][2], cur[2 * i + 1][3]};
                                    O[vb] = mfma32(af, pf[g >> 1], O[vb]); }
                            }
#undef VLD
                        }
                    }
                }
            }
            if (t + 2 < NT) asm volatile("s_waitcnt vmcnt(6)" ::: "memory"); else asm volatile("s_waitcnt vmcnt(0)" ::: "memory");
            __syncthreads();
            bb = (bb == 2) ? 0 : bb + 1;
        }
        const float ltot = lrun + __shfl_xor(lrun, 32); const float inv = __builtin_amdgcn_rcpf(ltot);
        int tle = tid_in; asm volatile("" : "+v"(tle));
        const int hl = (tle >> 5) & 1; const size_t grow = (size_t)b * SEQL + q0 + 32 * w + (tle & 31);
        bf16_t* stash = mix + ((size_t)(blockIdx.x * 8 + w) * 16) * 512 + (tle & 63) * 8;
        if (j == 0) {
#pragma unroll
            for (int vb = 0; vb < 8; ++vb) {
                float x[16];
#pragma unroll
                for (int r = 0; r < 16; ++r) x[r] = O[vb][r] * inv;
                u32x4 a, c;
                a.x = cvt_pk_bf16(x[0], x[1]); a.y = cvt_pk_bf16(x[2], x[3]); a.z = cvt_pk_bf16(x[4], x[5]); a.w = cvt_pk_bf16(x[6], x[7]);
                c.x = cvt_pk_bf16(x[8], x[9]); c.y = cvt_pk_bf16(x[10], x[11]); c.z = cvt_pk_bf16(x[12], x[13]); c.w = cvt_pk_bf16(x[14], x[15]);
                *(u32x4*)(stash + (2 * vb) * 512) = a; *(u32x4*)(stash + (2 * vb + 1) * 512) = c;
            }
        } else {
            float ss = 0.f; float ov[128];
#pragma unroll
            for (int vb = 0; vb < 8; ++vb) {
                const u32x4 a = *(const u32x4*)(stash + (2 * vb) * 512), c = *(const u32x4*)(stash + (2 * vb + 1) * 512);
                const float o1[16] = {bflo(a.x), bfhi(a.x), bflo(a.y), bfhi(a.y), bflo(a.z), bfhi(a.z), bflo(a.w), bfhi(a.w), bflo(c.x), bfhi(c.x), bflo(c.y), bfhi(c.y), bflo(c.z), bfhi(c.z), bflo(c.w), bfhi(c.w)};
                const float li = lam * inv;
#pragma unroll
                for (int r = 0; r < 16; ++r) { const float o = o1[r] - li * O[vb][r]; ov[vb * 16 + r] = o; ss += o * o; }
            }
            const float sst = ss + __shfl_xor(ss, 32);
            const float rstd = rsqrtf(sst * (1.f / 256.f) + 1e-6f) * oscale;
            asm volatile("s_waitcnt vmcnt(0)" ::: "memory");
            const bf16_t* gp = proj + grow * 8192 + 6144 + h * 256; bf16_t* op = (bf16_t*)proj + grow * 8192 + 6144 + h * 256;
            u32x2 ggv[32];
#pragma unroll
            for (int i = 0; i < 32; ++i) ggv[i] = *(const u32x2*)(gp + 32 * (i >> 2) + 8 * (i & 3) + 4 * hl);
            const float* sln = (const float*)(lds + SUBLN_OFF);
#pragma unroll
            for (int vb = 0; vb < 8; ++vb)
#pragma unroll
                for (int rg = 0; rg < 4; ++rg) {
                    const int e = 32 * vb + 8 * rg + 4 * hl;
                    const u32x2 gg = ggv[4 * vb + rg]; const f32x4 sg = *(const f32x4*)(sln + e);
                    u32x2 wv; wv.x = cvt_pk_bf16(ov[vb * 16 + 4 * rg] * rstd * sg[0] * bflo(gg.x), ov[vb * 16 + 4 * rg + 1] * rstd * sg[1] * bfhi(gg.x));
                    wv.y = cvt_pk_bf16(ov[vb * 16 + 4 * rg + 2] * rstd * sg[2] * bflo(gg.y), ov[vb * 16 + 4 * rg + 3] * rstd * sg[3] * bfhi(gg.y));
                    *(u32x2*)(op + e) = wv;
                }
        }
    }
}


typedef __attribute__((address_space(1))) unsigned gu32;
#define RLX_AGENT __ATOMIC_RELAXED, __HIP_MEMORY_SCOPE_AGENT
#define XB_TMO      128
#define XB_XCNT(j)  (256  + 64 * (j))
#define XB_XSUB(j)  (1280 + 64 * (j))
#define XB_XGEN(j)  (2304 + 64 * (j))
#define XB_TOP      3328
#define XB_TOPGEN   3392
#define XCD_BAR_WORDS 3456
#define XB_SPIN_CAP (1u << 18)

__device__ __forceinline__ unsigned xb_ld(unsigned* p)              { return __hip_atomic_load(p, __ATOMIC_RELAXED, __HIP_MEMORY_SCOPE_AGENT); }
__device__ __forceinline__ unsigned xb_add(unsigned* p, unsigned v) { return __hip_atomic_fetch_add(p, v, __ATOMIC_RELAXED, __HIP_MEMORY_SCOPE_AGENT); }
__device__ __forceinline__ unsigned xb_xcc_id() { return (unsigned)__builtin_amdgcn_s_getreg((3 << 11) | 20) & 0xFu; }
#define XB_SPIN(cond, bar) do { unsigned _sp = 0; while (cond) { __builtin_amdgcn_s_sleep(1); \
    if ((++_sp & 255u) == 0u) { if (xb_ld(&(bar)[XB_TMO])) break; if (_sp > XB_SPIN_CAP) { atomicAdd(&(bar)[XB_TMO], 1u); break; } } } } while (0)

struct XcdBarrier {
    unsigned* bar; unsigned x;
    volatile LAS unsigned* st;
};

__device__ __forceinline__ XcdBarrier xcd_barrier_post(unsigned* bar, volatile LAS unsigned* st) {
    XcdBarrier b; b.bar = bar; b.x = xb_xcc_id(); b.st = st;
    if (threadIdx.x == 0) (void)xb_add(&bar[XB_XCNT(b.x)], 1u);
    return b;
}
__device__ __forceinline__ void xcd_barrier_complete(unsigned* bar, unsigned x, unsigned& nloc, unsigned& nx) {
    const unsigned G = gridDim.x * gridDim.y * gridDim.z;
    unsigned sum, cnt, mine, sp = 0u;
    for (;;) {
        sum = 0u; cnt = 0u; mine = 0u;
#pragma unroll
        for (unsigned j = 0; j < 16; ++j) { const unsigned c = xb_ld(&bar[XB_XCNT(j)]); sum += c; cnt += (c > 0u) ? 1u : 0u; mine = (j == x) ? c : mine; }
        if (sum == G) break;
        __builtin_amdgcn_s_sleep(1);
        if ((++sp & 255u) == 0u) { if (xb_ld(&bar[XB_TMO])) break; if (sp > XB_SPIN_CAP) { atomicAdd(&bar[XB_TMO], 1u); break; } }
    }
    nloc = mine > 0u ? mine : 1u; nx = cnt > 0u ? cnt : 1u;
}

__device__ __forceinline__ void xcd_barrier(const XcdBarrier& b) {
    asm volatile("s_waitcnt vmcnt(0)" ::: "memory");
    __syncthreads();
    if (threadIdx.x == 0) {
        unsigned* bar = b.bar;
        __builtin_amdgcn_s_waitcnt(0);
        unsigned nloc = b.st[0], nx = b.st[1];
        if (nloc == 0u) { xcd_barrier_complete(bar, b.x, nloc, nx); b.st[0] = nloc; b.st[1] = nx; }
        const unsigned old = xb_add(&bar[XB_XSUB(b.x)], 1u);
        const unsigned gen = old / nloc;
        if (old + 1u == (gen + 1u) * nloc) {
            __builtin_amdgcn_fence(__ATOMIC_RELEASE, "agent");
            asm volatile("s_waitcnt vmcnt(0)" ::: "memory");
            const unsigned og = xb_add(&bar[XB_TOP], 1u);
            const unsigned tg = og / nx;
            if (og + 1u == (tg + 1u) * nx) xb_add(&bar[XB_TOPGEN], 1u);
            else XB_SPIN(xb_ld(&bar[XB_TOPGEN]) == tg, bar);
            __builtin_amdgcn_fence(__ATOMIC_ACQUIRE, "agent");
            xb_add(&bar[XB_XGEN(b.x)], 1u);
            asm volatile("s_waitcnt vmcnt(0)" ::: "memory");
        } else {
            XB_SPIN(xb_ld(&bar[XB_XGEN(b.x)]) == gen, bar);
            __builtin_amdgcn_fence(__ATOMIC_ACQUIRE, "agent");
            asm volatile("s_waitcnt vmcnt(0)" ::: "memory");
        }
    }
    __syncthreads();
}

struct Params { const float* in[27]; float* out; unsigned char* ws; int ph_lo, ph_hi; };
constexpr int N_PHASES = 16;

__global__ void __launch_bounds__(512, 2) mega_fwd(Params P) {
    extern __shared__ __attribute__((aligned(16))) unsigned char lds[];
    cg::grid_group grid = cg::this_grid();
    const int lo = P.ph_lo, hi = P.ph_hi;
    volatile LAS unsigned* MISC = (volatile LAS unsigned*)((LAS unsigned char*)lds + (LDS_BYTES - 64));
    if (threadIdx.x < 2) MISC[threadIdx.x] = 0u;
    __syncthreads();
    const XcdBarrier bar = xcd_barrier_post((unsigned*)P.ws, MISC);
#ifndef PHMASK
#define PHMASK 0xffff
#endif
#define IN(k) (((PHMASK >> (k)) & 1) && lo <= (k) && (k) < hi)
#ifndef DUPMASK
#define DUPMASK 0
#endif
#define DUP(k) ((DUPMASK >> (k)) & 1)
#define SEAM(k) do { if (IN(k) && IN((k) + 1)) { if ((k) == 0) grid.sync(); else xcd_barrier(bar); } } while (0)
#define FRAME() \
    int tid = threadIdx.x; asm volatile("" : "+v"(tid)); \
    const int lane = tid & 63, wave = tid >> 6; \
    int G = gridDim.x, bx = blockIdx.x; asm volatile("" : "+s"(G), "+s"(bx)); \
    const int vcu = (G % 8 == 0) ? (bx % 8) * (G / 8) + bx / 8 : bx; \
    __attribute__((address_space(1))) unsigned char* wsg_ = (__attribute__((address_space(1))) unsigned char*)P.ws; asm volatile("" : "+s"(wsg_)); unsigned char* ws = (unsigned char*)wsg_; \
    bf16_t* XN = (bf16_t*)(ws + WS_XN); bf16_t* PROJ = (bf16_t*)(ws + WS_PROJ); bf16_t* YAP = (bf16_t*)(ws + WS_YAP); bf16_t* XA2 = (bf16_t*)(ws + WS_PROJ + 192 * MiB); (void)XA2; \
    const int gw = vcu * 8 + wave, NGW = G * 8; \
    (void)lane; (void)gw; (void)NGW; (void)XN; (void)PROJ; (void)YAP;
#define SSQ(k) ((float*)(ws + 65536 + (k) * 65536))

    if (IN(0)) {
        FRAME();
        for (int it = vcu; it < 4480; it += G) {
            int r = it; const int jl = r / 2240; r -= jl * 2240;
            unsigned char* wb = ws + WS_W + jl * W_PER;
            if (r < 640) { transpose_block(P.in[2] + (size_t)jl * 2048 * 5120, 2048, 5120, (bf16_t*)(wb + W_INE), (float*)lds, r, tid, P.in[1] + jl * 2048); continue; } r -= 640;
            if (r < 64) { transpose_block(P.in[11] + (size_t)jl * 1024 * 1024, 1024, 1024, (bf16_t*)(wb + W_GLU), (float*)lds, r, tid, nullptr); continue; } r -= 64;
            if (r < 256) { transpose_block(P.in[17] + (size_t)jl * 2048 * 2048, 2048, 2048, (bf16_t*)(wb + W_OUTE), (float*)lds, r, tid, nullptr); continue; } r -= 256;
            if (r < 1024) { transpose_block(P.in[19] + (size_t)jl * 2048 * 8192, 2048, 8192, (bf16_t*)(wb + W_INO), (float*)lds, r, tid, P.in[18] + jl * 2048); continue; } r -= 1024;
            transpose_block(P.in[25] + (size_t)jl * 2048 * 2048, 2048, 2048, (bf16_t*)(wb + W_OUTO), (float*)lds, r, tid, nullptr);
        }
        { int m = gw;
          for (; m + 3 * NGW < MROWS; m += 4 * NGW) xb_rows4(P.in[0], XN, SSQ(0), m, NGW, lane);
          for (; m < MROWS; m += NGW) xb_row(P.in[0] + (size_t)m * DM, XN + (size_t)m * DM, SSQ(0) + m, lane); }
        for (int i = bx * 512 + tid; i < 32768; i += G * 512) {
            const int idx = i * 8, sp = idx & 127, t = (idx >> 7) & 127;
            const f32x4 w0 = *(const f32x4*)(P.in[15] + idx), w1 = *(const f32x4*)(P.in[15] + idx + 4);
            float wv[8] = {w0[0], w0[1], w0[2], w0[3], w1[0], w1[1], w1[2], w1[3]};
#pragma unroll
            for (int e = 0; e < 8; ++e) if (sp + e > t) wv[e] = 0.f;
            *(bf16x8*)((bf16_t*)(ws + 524288) + idx) = pack8(wv);
        }
        for (int i = bx * 512 + tid; i < 65536; i += G * 512) {
            const int pos = i >> 4, fi = i & 15;
            const float invf = (float)exp2(-(double)fi * (18.931568569324174 / 16.0));
            const float ang = (float)pos * invf; float s, c; sincos_red((double)ang, s, c);
            ((float*)(ws + WS_ROPE))[i] = c; ((float*)(ws + WS_ROPE))[65536 + i] = s;
        }
        __syncthreads();
        for (int combo = bx; combo < 128; combo += G)
            s5_tables(combo >> 6, combo & 63, P.in[3], P.in[4], P.in[5], P.in[6], P.in[7], P.in[8], P.in[9], P.in[10], ws, (float*)lds, tid);
    }
    SEAM(0);

#define OUT_PROJ(PH, AOP, LDA, WOFF, XRES, LAST, SQ) \
    if (IN(PH)) { FRAME(); \
        pg8::Gemm g{AOP, (const bf16_t*)(ws + WS_W + WOFF), MROWS, 2048, 2048, LDA}; pg8::StaticOrder S; S.init(MROWS, 2048, G, bx); \
        if (LAST) { pg8::EpiResid E{XRES, P.out}; pg8::gemm_phase<pg8::EpiResid, pg8::StaticOrder, true, true>((LAS unsigned char*)lds, g, S, E, tid); } \
        else { pg8::EpiResidStat E{XRES, P.out, XN, SSQ(SQ)}; pg8::gemm_phase<pg8::EpiResidStat, pg8::StaticOrder, true, true>((LAS unsigned char*)lds, g, S, E, tid); } } \
    SEAM(PH);

#define EVEN_LAYER(PH0, JL, XRES, SQ) \
    if (IN(PH0)) { FRAME(); \
        pg8::Gemm g{XN, (const bf16_t*)(ws + WS_W + (JL) * W_PER + W_INE), MROWS, 5120, 2048, 2048}; pg8::StaticOrder S; S.init(MROWS, 5120, G, bx); \
        pg8::EpiEvenProj E{PROJ, SSQ(SQ), XA2}; \
        pg8::gemm_phase<pg8::EpiEvenProj, pg8::StaticOrder, true, true>((LAS unsigned char*)lds, g, S, E, tid); } \
    SEAM(PH0); \
    if (IN(PH0 + 1)) { FRAME(); \
        for (int it = vcu; it < 256; it += G) { const int b = it >> 6, g = it & 63; \
            s5_item(b, g, ws + WS_S5 + (size_t)((JL) * 64 + g) * 262144, (const float*)(ws + WS_AT) + ((JL) * 64 + g) * 128, XA2, YAP, lds, tid); } \
        for (int it = vcu; it < 256; it += G) { const int b = it >> 6, nc = (it >> 1) & 31, gh = it & 1; \
            sgu_item(b, nc, gh, PROJ, XN, P.in[13] + (JL) * 1024, P.in[14] + (JL) * 1024, (const bf16_t*)(ws + 524288) + (size_t)(JL) * 8 * 128 * 128, P.in[16] + (JL) * 1024, lds, tid); } } \
    SEAM(PH0 + 1); \
    if (IN(PH0 + 2)) { FRAME(); \
        pg8::Gemm g{YAP, (const bf16_t*)(ws + WS_W + (JL) * W_PER + W_GLU), MROWS, 1024, 1024, 1024}; pg8::StaticOrder S; S.init(MROWS, 1024, G, bx); \
        pg8::EpiGlu E{YAP, PROJ, P.in[12] + (JL) * 1024, PROJ + 1024}; \
        pg8::gemm_phase<pg8::EpiGlu, pg8::StaticOrder, true, true>((LAS unsigned char*)lds, g, S, E, tid); } \
    SEAM(PH0 + 2); \
    OUT_PROJ(PH0 + 3, PROJ + 1024, 5120, (JL) * W_PER + W_OUTE, XRES, false, (SQ) + 1)

#define ODD_LAYER(PH0, JL, LAYER, LAST, SQ) \
    if (IN(PH0)) { FRAME(); \
        pg8::Gemm g{XN, (const bf16_t*)(ws + WS_W + (JL) * W_PER + W_INO), MROWS, 8192, 2048, 2048}; pg8::StaticOrder S; S.init(MROWS, 8192, G, bx); \
        pg8::EpiOddProj E{PROJ, (const float*)(ws + WS_ROPE), SSQ(SQ)}; \
        pg8::gemm_phase<pg8::EpiOddProj, pg8::StaticOrder, true, true>((LAS unsigned char*)lds, g, S, E, tid); } \
    SEAM(PH0); \
    if (IN(PH0 + 1)) { FRAME(); \
        float d1 = 0.f, d2 = 0.f; \
        for (int i = 0; i < 128; ++i) { d1 += P.in[20][(JL) * 128 + i] * P.in[21][(JL) * 128 + i]; d2 += P.in[22][(JL) * 128 + i] * P.in[23][(JL) * 128 + i]; } \
        const float lam_init = 0.8f - 0.6f * expf(-0.3f * (float)(LAYER)); \
        const float lam = expf(d1) - expf(d2) + lam_init; \
        if (tid < 256) ((float*)(lds + SUBLN_OFF))[tid] = (P.in[24] + (JL) * 256)[tid]; \
        __syncthreads(); \
        for (int it = vcu; it < 256; it += G) { const int b = it >> 6, h = (it >> 3) & 7, x = it & 7; \
            attn_unit(b, h, 15 - x, PROJ, XN, lam, P.in[24] + (JL) * 256, 1.f - lam_init, lds, tid); \
            attn_unit(b, h, x, PROJ, XN, lam, P.in[24] + (JL) * 256, 1.f - lam_init, lds, tid); } } \
    SEAM(PH0 + 1); \
    OUT_PROJ(PH0 + 2, PROJ + 6144, 8192, (JL) * W_PER + W_OUTO, P.out, LAST, (SQ) + 1)

    EVEN_LAYER(1, 0, P.in[0], 0)
    ODD_LAYER(5, 0, 1, false, 1)
    EVEN_LAYER(8, 1, P.out, 2)
    ODD_LAYER(12, 1, 3, true, 3)
    if (IN(15)) { FRAME();
        int m = gw;
        for (; m + 3 * NGW < MROWS; m += 4 * NGW) rms_rows4_final(P.out, m, NGW, P.in[26], lane);
        for (; m < MROWS; m += NGW) rms_row<true>(P.out + (size_t)m * DM, P.in[26], nullptr, P.out + (size_t)m * DM, lane); }
#undef IN
#undef SEAM
#undef FRAME
}


extern "C" void kernel_launch(void* const* d_in, const int* in_sizes, int n_in, void* d_out, int out_size, void* d_ws, size_t ws_size, hipStream_t stream) {
    static int grid = 0;
    if (grid == 0) {
        if (n_in != 27 || ws_size < WS_END) { fprintf(stderr, "kernel_launch: unexpected n_in %d or ws_size %zu\n", n_in, ws_size); grid = -1; return; }
        int dev = 0, cus = 0, per_cu = 0;
        hipGetDevice(&dev); hipDeviceGetAttribute(&cus, hipDeviceAttributeMultiprocessorCount, dev);
        hipFuncSetAttribute((const void*)mega_fwd, hipFuncAttributeMaxDynamicSharedMemorySize, LDS_BYTES);
        hipOccupancyMaxActiveBlocksPerMultiprocessor(&per_cu, (const void*)mega_fwd, 512, LDS_BYTES);
        if (per_cu < 1) { fprintf(stderr, "kernel_launch: occupancy query says %d blocks per CU\n", per_cu); per_cu = 1; }
        (void)hipGetLastError();
        grid = cus * 1;
    }
    if (grid < 0) return;
    if (hipMemsetAsync(d_ws, 0, 524288, stream) != hipSuccess) { fprintf(stderr, "kernel_launch: memset failed\n"); return; }
    Params p{};
    for (int i = 0; i < 27; ++i) p.in[i] = (const float*)d_in[i];
    p.out = (float*)d_out; p.ws = (unsigned char*)d_ws; p.ph_lo = 0; p.ph_hi = N_PHASES;
    void* args[] = {&p};
    hipError_t e = hipLaunchCooperativeKernel((const void*)mega_fwd, dim3(grid), dim3(512), args, LDS_BYTES, stream);
    if (e != hipSuccess) fprintf(stderr, "cooperative launch failed: %s (grid %d)\n", hipGetErrorString(e), grid);
}
```

```cpp
#include <hip/hip_runtime.h>
#include <cstdio>
#include <cstdint>
#include <cmath>
namespace pg8 {
#define PG8_LAS __attribute__((address_space(3)))
typedef unsigned short bf16_t;
typedef short bf16x8 __attribute__((ext_vector_type(8)));
typedef float f32x4 __attribute__((ext_vector_type(4)));
typedef unsigned u32x4 __attribute__((ext_vector_type(4)));
constexpr int BM = 256, BK = 64, HALF = 128, HTB = HALF * BK * 2  , STAGE_BYTES = 8 * HTB, NXCD = 8, WGM = 8;

__host__ __device__ __forceinline__ int lds_byte(int r, int c) { const int st = (r >> 4) * 2 + (c >> 5), rr = r & 15, cc = c & 31, ob = rr * 64 + cc * 2; return st * 1024 + (ob ^ (((ob >> 9) & 1) << 5)); }
__host__ __device__ __forceinline__ void stage_rc(int b, int& R, int& C) { const int st = b / 1024, sb = b % 1024, swz = sb ^ (((sb >> 9) & 1) << 5); R = (st >> 1) * 16 + swz / 64; C = (st & 1) * 32 + (swz % 64) / 2; }
__host__ __device__ __forceinline__ int perm32(int rho) { const int n = rho >> 4, i = rho & 15; return 8 * (i >> 2) + 4 * n + (i & 3); }

struct Unit { int pm, pn; };
struct Gemm { const bf16_t* A; const bf16_t* Bt; int M, N, K, lda; };

struct StaticOrder {
    int nM, nN, nwg, G, c;
    __host__ __device__ void init(int M, int N, int G_, int c_) { nM = M / BM; nN = N / BM; nwg = nM * nN; G = G_; c = c_; }
    __host__ __device__ bool next(int i, Unit& u) const {
        const long L = (long)i * G + c; if (L >= nwg) return false;
        int wgid = (int)L; { const int q = nwg / NXCD, r = nwg % NXCD, xcd = wgid % NXCD, off = wgid / NXCD; wgid = (xcd < r ? xcd * (q + 1) : r * (q + 1) + (xcd - r) * q) + off; }
        const int nig = WGM * nN, gid = wgid / nig, fm = gid * WGM, gsz = (nM - fm) < WGM ? (nM - fm) : WGM;
        u.pm = fm + ((wgid % nig) % gsz); u.pn = (wgid % nig) / gsz; return true;
    }
    __device__ __forceinline__ void a_ready(const Unit&) const {}
    __device__ __forceinline__ void done(const Unit&) const {}
};

__device__ __forceinline__ unsigned cvt_pk_bf16(float lo, float hi) { unsigned r; asm volatile("v_cvt_pk_bf16_f32 %0, %1, %2" : "=v"(r) : "v"(lo), "v"(hi)); return r; }
typedef float f32x2 __attribute__((ext_vector_type(2)));
__device__ __forceinline__ float silu_f(float v) { return v * __builtin_amdgcn_rcpf(1.f + __expf(-v)); }
__device__ __forceinline__ float sigmoid_f(float v) { return __builtin_amdgcn_rcpf(1.f + __expf(-v)); }
__device__ __forceinline__ float gelu_tanh_f(float v) { const float u = 0.7978845608028654f * (v + 0.044715f * v * v * v); return v * __builtin_amdgcn_rcpf(1.f + __expf(-2.f * u)); }
__device__ __forceinline__ float bf2f(unsigned short b) { return __uint_as_float(((unsigned)b) << 16); }
__device__ __forceinline__ float bflo(unsigned w) { return __uint_as_float(w << 16); }
__device__ __forceinline__ float bfhi(unsigned w) { return __uint_as_float(w & 0xffff0000u); }

struct EpiEvenProj {
    static constexpr bool PERM = true, AFTER_DRAIN = false;
    bf16_t* O; const float* ssq; bf16_t* xa2;
    __device__ __forceinline__ void operator()(const f32x4 (&acc)[2][2][4][2], const Unit& u, int wr, int wc, int fr, int fq) const {
        const int row0 = u.pm * BM + wr * 64 + fr, col0 = u.pn * BM + wc * 32 + 8 * fq;
        const int act = (u.pn < 4) ? 0 : (u.pn < 8) ? 1 : (u.pn < 16) ? 2 : 1;
        float rsv[2][4];
#pragma unroll
        for (int ai = 0; ai < 2; ++ai)
#pragma unroll
            for (int m = 0; m < 4; ++m) rsv[ai][m] = ssq[row0 + ai * HALF + m * 16];
#pragma unroll
        for (int ai = 0; ai < 2; ++ai)
#pragma unroll
            for (int m = 0; m < 4; ++m) rsv[ai][m] = rsqrtf(rsv[ai][m] * (1.f / 2048.f) + 1e-6f);
#pragma unroll
        for (int ai = 0; ai < 2; ++ai)
#pragma unroll
            for (int m = 0; m < 4; ++m) { bf16_t* rowp = O + (size_t)(row0 + ai * HALF + m * 16) * 5120 + col0; const float rs = rsv[ai][m];
#pragma unroll
                for (int bj = 0; bj < 2; ++bj) { f32x4 v0 = acc[ai][bj][m][0] * rs, v1 = acc[ai][bj][m][1] * rs;
                    if (act == 1) {
#pragma unroll
                        for (int e = 0; e < 4; ++e) { v0[e] = silu_f(v0[e]); v1[e] = silu_f(v1[e]); } }
                    else if (act == 2) {
#pragma unroll
                        for (int e = 0; e < 4; ++e) { v0[e] = gelu_tanh_f(v0[e]); v1[e] = gelu_tanh_f(v1[e]); } }
                    u32x4 w; w.x = cvt_pk_bf16(v0[0], v0[1]); w.y = cvt_pk_bf16(v0[2], v0[3]); w.z = cvt_pk_bf16(v1[0], v1[1]); w.w = cvt_pk_bf16(v1[2], v1[3]);
                    if (act == 0) { const int rr = row0 + ai * HALF + m * 16, cc = col0 + bj * HALF;
                        *(u32x4*)(xa2 + ((size_t)((rr >> 12) * 64 + (cc >> 4)) * 4096 + (rr & 4095)) * 16 + (cc & 8)) = w; }
                    else *(u32x4*)(rowp + bj * HALF) = w; } }
    }
};
struct EpiOddProj {
    static constexpr bool PERM = true, AFTER_DRAIN = false;
    bf16_t* O; const float* cs; const float* ssq;
    __device__ __forceinline__ void operator()(const f32x4 (&acc)[2][2][4][2], const Unit& u, int wr, int wc, int fr, int fq) const {
        const int row0 = u.pm * BM + wr * 64 + fr, col0 = u.pn * BM + wc * 32 + 8 * fq;
        const int kind = u.pn >> 3;
        const float C2 = 0.08838834764831845f * 1.4426950408889634f;
        const float sgn = (fq < 2) ? -1.f : 1.f; const int fi = 8 * (fq & 1);
        float rsv[2][4];
#pragma unroll
        for (int ai = 0; ai < 2; ++ai)
#pragma unroll
            for (int m = 0; m < 4; ++m) rsv[ai][m] = ssq[row0 + ai * HALF + m * 16];
#pragma unroll
        for (int ai = 0; ai < 2; ++ai)
#pragma unroll
            for (int m = 0; m < 4; ++m) rsv[ai][m] = rsqrtf(rsv[ai][m] * (1.f / 2048.f) + 1e-6f);
        const bool rope = (kind < 2) && (wc == 0);
#pragma unroll
        for (int ah = 0; ah < 4; ++ah) { const int ai = ah >> 1;
            f32x4 ct[2][4];
            if (rope) {
#pragma unroll
                for (int mm = 0; mm < 2; ++mm) { const int pos = (row0 + ai * HALF + (2 * (ah & 1) + mm) * 16) & 4095;
                    ct[mm][0] = *(const f32x4*)(cs + pos * 16 + fi); ct[mm][1] = *(const f32x4*)(cs + pos * 16 + fi + 4);
                    ct[mm][2] = *(const f32x4*)(cs + 65536 + pos * 16 + fi); ct[mm][3] = *(const f32x4*)(cs + 65536 + pos * 16 + fi + 4); }
            }
#pragma unroll
            for (int mm = 0; mm < 2; ++mm) { const int m = 2 * (ah & 1) + mm; const int row = row0 + ai * HALF + m * 16; bf16_t* rowp = O + (size_t)row * 8192 + col0; const float rs = rsv[ai][m];
#pragma unroll
                for (int bj = 0; bj < 2; ++bj) { f32x4 v0 = acc[ai][bj][m][0] * rs, v1 = acc[ai][bj][m][1] * rs;
                    if (kind < 2) {
                        if (wc == 0) {
                            f32x4 p0, p1;
#pragma unroll
                            for (int e = 0; e < 4; ++e) { p0[e] = __shfl_xor(v0[e], 32); p1[e] = __shfl_xor(v1[e], 32); }
                            const f32x4 c0 = ct[mm][0], c1 = ct[mm][1], s0 = ct[mm][2], s1 = ct[mm][3];
                            v0 = v0 * c0 + (p0 * s0) * sgn; v1 = v1 * c1 + (p1 * s1) * sgn;
                        }
                        if (kind == 0) { v0 = v0 * C2; v1 = v1 * C2; }
                    } else if (kind == 3) {
#pragma unroll
                        for (int e = 0; e < 4; ++e) { v0[e] = silu_f(v0[e]); v1[e] = silu_f(v1[e]); } }
                    u32x4 w; w.x = cvt_pk_bf16(v0[0], v0[1]); w.y = cvt_pk_bf16(v0[2], v0[3]); w.z = cvt_pk_bf16(v1[0], v1[1]); w.w = cvt_pk_bf16(v1[2], v1[3]);
                    *(u32x4*)(rowp + bj * HALF) = w; } }
        }
    }
};
struct EpiGlu {
    static constexpr bool PERM = true, AFTER_DRAIN = false;
    const bf16_t* yap; const bf16_t* proj; const float* bglu; bf16_t* mix;
    __device__ __forceinline__ void operator()(const f32x4 (&acc)[2][2][4][2], const Unit& u, int wr, int wc, int fr, int fq) const {
        const int row0 = u.pm * BM + wr * 64 + fr, col0 = u.pn * BM + wc * 32 + 8 * fq;
        f32x4 bb[2][2];
#pragma unroll
        for (int bj = 0; bj < 2; ++bj) { bb[bj][0] = *(const f32x4*)(bglu + col0 + bj * HALF); bb[bj][1] = *(const f32x4*)(bglu + col0 + bj * HALF + 4); }
#pragma unroll
        for (int ai = 0; ai < 2; ++ai) {
            u32x4 yv[4][2], gv[4][2];
#pragma unroll
            for (int m = 0; m < 4; ++m)
#pragma unroll
                for (int bj = 0; bj < 2; ++bj) { const size_t row = (size_t)(row0 + ai * HALF + m * 16); const int c = col0 + bj * HALF;
                    yv[m][bj] = *(const u32x4*)(yap + row * 1024 + c); gv[m][bj] = *(const u32x4*)(proj + row * 5120 + 1024 + c); }
#pragma unroll
            for (int m = 0; m < 4; ++m) { const size_t row = (size_t)(row0 + ai * HALF + m * 16);
#pragma unroll
                for (int bj = 0; bj < 2; ++bj) { const int c = col0 + bj * HALF;
                    const u32x4 y8 = yv[m][bj], g8 = gv[m][bj];
                    const f32x4 a0 = acc[ai][bj][m][0] + bb[bj][0], a1 = acc[ai][bj][m][1] + bb[bj][1];
                    float o[8];
                    o[0] = bflo(y8.x) * sigmoid_f(a0[0]) * bflo(g8.x); o[1] = bfhi(y8.x) * sigmoid_f(a0[1]) * bfhi(g8.x);
                    o[2] = bflo(y8.y) * sigmoid_f(a0[2]) * bflo(g8.y); o[3] = bfhi(y8.y) * sigmoid_f(a0[3]) * bfhi(g8.y);
                    o[4] = bflo(y8.z) * sigmoid_f(a1[0]) * bflo(g8.z); o[5] = bfhi(y8.z) * sigmoid_f(a1[1]) * bfhi(g8.z);
                    o[6] = bflo(y8.w) * sigmoid_f(a1[2]) * bflo(g8.w); o[7] = bfhi(y8.w) * sigmoid_f(a1[3]) * bfhi(g8.w);
                    u32x4 w; w.x = cvt_pk_bf16(o[0], o[1]); w.y = cvt_pk_bf16(o[2], o[3]); w.z = cvt_pk_bf16(o[4], o[5]); w.w = cvt_pk_bf16(o[6], o[7]);
                    *(u32x4*)(mix + row * 5120 + c) = w; } }
        }
    }
};
struct EpiResid {
    static constexpr bool PERM = false, AFTER_DRAIN = false;
    const float* base; float* out;
    __device__ __forceinline__ void operator()(const f32x4 (&acc)[2][2][4][2], const Unit& u, int wr, int wc, int fr, int fq) const {
        const int row0 = u.pm * BM + wr * 64 + fr, col0 = u.pn * BM + wc * 32 + 4 * fq;
#pragma unroll
        for (int ai = 0; ai < 2; ++ai) {
            f32x4 bv[4][2][2];
#pragma unroll
            for (int m = 0; m < 4; ++m) { const size_t off = (size_t)(row0 + ai * HALF + m * 16) * 2048 + col0;
#pragma unroll
                for (int bj = 0; bj < 2; ++bj)
#pragma unroll
                    for (int n = 0; n < 2; ++n) bv[m][bj][n] = *(const f32x4*)(base + off + bj * HALF + n * 16); }
#pragma unroll
            for (int m = 0; m < 4; ++m) { const size_t off = (size_t)(row0 + ai * HALF + m * 16) * 2048 + col0;
#pragma unroll
                for (int bj = 0; bj < 2; ++bj)
#pragma unroll
                    for (int n = 0; n < 2; ++n) *(f32x4*)(out + off + bj * HALF + n * 16) = bv[m][bj][n] + acc[ai][bj][m][n]; }
        }
    }
};
struct EpiResidStat {
    static constexpr bool PERM = false, AFTER_DRAIN = false;
    const float* base; float* out; bf16_t* xb; float* ssq;
    __device__ __forceinline__ void operator()(const f32x4 (&acc)[2][2][4][2], const Unit& u, int wr, int wc, int fr, int fq) const {
        const int row0 = u.pm * BM + wr * 64 + fr, col0 = u.pn * BM + wc * 32 + 4 * fq;
        typedef unsigned u32x2_t __attribute__((ext_vector_type(2)));
#pragma unroll
        for (int ai = 0; ai < 2; ++ai) {
            f32x4 bv[4][2][2];
#pragma unroll
            for (int m = 0; m < 4; ++m) { const size_t off = (size_t)(row0 + ai * HALF + m * 16) * 2048 + col0;
#pragma unroll
                for (int bj = 0; bj < 2; ++bj)
#pragma unroll
                    for (int n = 0; n < 2; ++n) bv[m][bj][n] = *(const f32x4*)(base + off + bj * HALF + n * 16); }
            float sqv[4];
#pragma unroll
            for (int m = 0; m < 4; ++m) { const int row = row0 + ai * HALF + m * 16; const size_t off = (size_t)row * 2048 + col0; float sq = 0.f;
#pragma unroll
                for (int bj = 0; bj < 2; ++bj)
#pragma unroll
                    for (int n = 0; n < 2; ++n) { const f32x4 o = bv[m][bj][n] + acc[ai][bj][m][n];
                        *(f32x4*)(out + off + bj * HALF + n * 16) = o; sq += (o[0] * o[0] + o[1] * o[1]) + (o[2] * o[2] + o[3] * o[3]);
                        u32x2_t w; w.x = cvt_pk_bf16(o[0], o[1]); w.y = cvt_pk_bf16(o[2], o[3]); *(u32x2_t*)(xb + off + bj * HALF + n * 16) = w; }
                sqv[m] = sq; }
#pragma unroll
            for (int m = 0; m < 4; ++m) { sqv[m] += __shfl_xor(sqv[m], 16); }
#pragma unroll
            for (int m = 0; m < 4; ++m) { sqv[m] += __shfl_xor(sqv[m], 32); }
#pragma unroll
            for (int m = 0; m < 4; ++m) if (fq == 0) atomicAdd(ssq + row0 + ai * HALF + m * 16, sqv[m]);
        }
    }
};

template <class Epi, class Sched, bool ALIGN_EPI = false, bool SP2 = false>
__device__ __forceinline__ void gemm_phase(PG8_LAS unsigned char* lds, const Gemm g, const Sched& S, const Epi& E, const int tid_in) {
    const int tid = tid_in, wid = __builtin_amdgcn_readfirstlane(tid >> 6), lane = tid & 63, wr = wid >> 2, wc = wid & 3, fr = lane & 15, fq = lane >> 4;
    const int K = g.K, nt = K / BK;
    unsigned voffA[2], voffB[2];
#pragma unroll
    for (int i = 0; i < 2; ++i) { int R, C; stage_rc(tid * 16 + i * 8192, R, C); const int Rb = Epi::PERM ? ((R & ~31) + perm32(R & 31)) : R;
        voffA[i] = (unsigned)(R * g.lda + C) * 2u; voffB[i] = (unsigned)(Rb * K + C) * 2u; }
    const size_t kstep = (size_t)(BK * 2);
    const size_t hstep = (size_t)HALF * K * 2;
    const size_t tstep = 2 * hstep;
    const size_t hstepA = (size_t)HALF * g.lda * 2, tstepA = 2 * hstepA;
    const unsigned ldsw = (unsigned)wid * 1024u;
    const int aoff = lds_byte(wr * 64 + fr, fq * 8), boff = lds_byte(wc * 32 + fr, fq * 8);
#define PG8_SA(b, h) (((b) * 2 + (h)) * HTB)
#define PG8_SB(b, h) ((4 + (b) * 2 + (h)) * HTB)
#define PG8_STAGE(bufoff, gbase, voff) do { _Pragma("unroll") for (int _i = 0; _i < 2; ++_i) \
        __builtin_amdgcn_global_load_lds((const unsigned*)((const char*)(gbase) + (voff)[_i]), (PG8_LAS unsigned*)(lds + (bufoff) + ldsw + _i * 8192), 16, 0, 0); } while (0)
#define PG8_LDA(dst, b, h) do { _Pragma("unroll") for (int m = 0; m < 4; ++m) _Pragma("unroll") for (int k = 0; k < 2; ++k) dst[m][k] = *(const PG8_LAS bf16x8*)(lds + PG8_SA(b, h) + aoff + m * 2048 + k * 1024); } while (0)
#define PG8_LDB(dst, b, h) do { _Pragma("unroll") for (int n = 0; n < 2; ++n) _Pragma("unroll") for (int k = 0; k < 2; ++k) dst[n][k] = *(const PG8_LAS bf16x8*)(lds + PG8_SB(b, h) + boff + n * 2048 + k * 1024); } while (0)
#define PG8_MMA(ai, bj, At, Bt) do { __builtin_amdgcn_s_setprio(1); _Pragma("unroll") for (int m = 0; m < 4; ++m) _Pragma("unroll") for (int n = 0; n < 2; ++n) _Pragma("unroll") for (int k = 0; k < 2; ++k) \
        acc[ai][bj][m][n] = __builtin_amdgcn_mfma_f32_16x16x32_bf16(Bt[n][k], At[m][k], acc[ai][bj][m][n], 0, 0, 0); __builtin_amdgcn_s_setprio(0); } while (0)
#define PG8_WAIT_V(n) asm volatile("s_waitcnt vmcnt(" #n ")" ::: "memory")
#define PG8_WAIT_L(n) asm volatile("s_waitcnt lgkmcnt(" #n ")" ::: "memory")
#define PG8_BAR __builtin_amdgcn_s_barrier()
#define PG8_SCHED __builtin_amdgcn_sched_barrier(0)
    Unit cur, nxt; int ui = 0;
    if (!S.next(0, cur)) return;
    f32x4 acc[2][2][4][2];
#pragma unroll
    for (int a = 0; a < 2; ++a)
#pragma unroll
        for (int b = 0; b < 2; ++b)
#pragma unroll
            for (int m = 0; m < 4; ++m)
#pragma unroll
                for (int n = 0; n < 2; ++n) acc[a][b][m][n] = (f32x4){0.f, 0.f, 0.f, 0.f};
    bf16x8 At[4][2], B0[2][2], B1[2][2];
    const char* cA = (const char*)g.A + (size_t)cur.pm * tstepA; const char* cB = (const char*)g.Bt + (size_t)cur.pn * tstep;
    S.a_ready(cur);
    if constexpr (SP2) {
        PG8_STAGE(PG8_SB(0, 0), cB, voffB); PG8_STAGE(PG8_SB(0, 1), cB + hstep, voffB); PG8_STAGE(PG8_SA(0, 0), cA, voffA); PG8_STAGE(PG8_SA(0, 1), cA + hstepA, voffA);
        if (wr == 1) PG8_BAR;
        PG8_WAIT_V(2); PG8_BAR;
        PG8_STAGE(PG8_SB(1, 0), cB + kstep, voffB); PG8_STAGE(PG8_SA(1, 0), cA + kstep, voffA); PG8_STAGE(PG8_SB(1, 1), cB + hstep + kstep, voffB);
        PG8_WAIT_V(6); PG8_BAR;
    } else {
        PG8_STAGE(PG8_SB(0, 0), cB, voffB); PG8_STAGE(PG8_SA(0, 0), cA, voffA); PG8_STAGE(PG8_SB(0, 1), cB + hstep, voffB); PG8_STAGE(PG8_SA(0, 1), cA + hstepA, voffA);
        if (wr == 1) PG8_BAR;
        PG8_WAIT_V(4); PG8_BAR;
        PG8_STAGE(PG8_SB(1, 0), cB + kstep, voffB); PG8_STAGE(PG8_SA(1, 0), cA + kstep, voffA); PG8_STAGE(PG8_SB(1, 1), cB + hstep + kstep, voffB);
        PG8_WAIT_V(6); PG8_BAR;
    }
    for (;;) {
        const bool has_next = S.next(ui + 1, nxt);
        const char* nA = has_next ? (const char*)g.A + (size_t)nxt.pm * tstepA : cA; const char* nB = has_next ? (const char*)g.Bt + (size_t)nxt.pn * tstep : cB;
        for (int t = 0; t < nt; t += 2) {
            const bool last = (t == nt - 2);
            const char* a1 = cA + (size_t)(t + 1) * kstep;
            const char* a2 = last ? nA : cA + (size_t)(t + 2) * kstep; const char* b2 = last ? nB : cB + (size_t)(t + 2) * kstep;
            const char* a3 = a2 + kstep; const char* b3 = b2 + kstep;
            if (last && has_next) S.a_ready(nxt);
            if constexpr (SP2) {
            PG8_LDB(B0, 0, 0); PG8_LDB(B1, 0, 1); PG8_SCHED; PG8_LDA(At, 0, 0); PG8_STAGE(PG8_SA(1, 1), a1 + hstepA, voffA);
            PG8_WAIT_V(8); PG8_WAIT_L(0); PG8_BAR; PG8_MMA(0, 0, At, B0); PG8_MMA(0, 1, At, B1); PG8_BAR; PG8_SCHED;
            PG8_LDA(At, 0, 1); PG8_STAGE(PG8_SB(0, 0), b2, voffB); PG8_STAGE(PG8_SB(0, 1), b2 + hstep, voffB); PG8_STAGE(PG8_SA(0, 0), a2, voffA);
            PG8_WAIT_V(8); PG8_WAIT_L(0); PG8_BAR; PG8_MMA(1, 0, At, B0); PG8_MMA(1, 1, At, B1); PG8_BAR; PG8_SCHED;
            PG8_LDB(B0, 1, 0); PG8_LDB(B1, 1, 1); PG8_SCHED; PG8_LDA(At, 1, 0); PG8_STAGE(PG8_SA(0, 1), a2 + hstepA, voffA);
            PG8_WAIT_V(8); PG8_WAIT_L(0); PG8_BAR; PG8_MMA(0, 0, At, B0); PG8_MMA(0, 1, At, B1); PG8_BAR; PG8_SCHED;
            PG8_LDA(At, 1, 1); PG8_STAGE(PG8_SB(1, 0), b3, voffB); PG8_STAGE(PG8_SB(1, 1), b3 + hstep, voffB); PG8_STAGE(PG8_SA(1, 0), a3, voffA);
            PG8_WAIT_V(8); PG8_WAIT_L(0); PG8_BAR; PG8_MMA(1, 0, At, B0); PG8_MMA(1, 1, At, B1); PG8_BAR; PG8_SCHED;
            } else {
            PG8_LDB(B0, 0, 0); PG8_SCHED; PG8_LDA(At, 0, 0); PG8_STAGE(PG8_SA(1, 1), a1 + hstepA, voffA);
            PG8_WAIT_L(8); PG8_BAR; PG8_WAIT_L(0); PG8_MMA(0, 0, At, B0); PG8_BAR; PG8_SCHED;
            PG8_LDB(B1, 0, 1); PG8_STAGE(PG8_SB(0, 0), b2, voffB);
            PG8_BAR; PG8_WAIT_L(0); PG8_MMA(0, 1, At, B1); PG8_BAR;
            PG8_LDA(At, 0, 1); PG8_STAGE(PG8_SA(0, 0), a2, voffA);
            PG8_BAR; PG8_WAIT_L(0); PG8_MMA(1, 0, At, B0); PG8_BAR; PG8_SCHED;
            PG8_STAGE(PG8_SB(0, 1), b2 + hstep, voffB);
            PG8_WAIT_V(6); PG8_BAR; PG8_MMA(1, 1, At, B1); PG8_BAR;
            PG8_LDB(B0, 1, 0); PG8_SCHED; PG8_LDA(At, 1, 0); PG8_STAGE(PG8_SA(0, 1), a2 + hstepA, voffA);
            PG8_WAIT_L(8); PG8_BAR; PG8_WAIT_L(0); PG8_MMA(0, 0, At, B0); PG8_BAR; PG8_SCHED;
            PG8_LDB(B1, 1, 1); PG8_STAGE(PG8_SB(1, 0), b3, voffB);
            PG8_BAR; PG8_WAIT_L(0); PG8_MMA(0, 1, At, B1); PG8_BAR;
            PG8_LDA(At, 1, 1); PG8_STAGE(PG8_SA(1, 0), a3, voffA);
            PG8_BAR; PG8_WAIT_L(0); PG8_MMA(1, 0, At, B0); PG8_BAR; PG8_SCHED;
            PG8_STAGE(PG8_SB(1, 1), b3 + hstep, voffB);
            PG8_WAIT_V(6); PG8_BAR; PG8_MMA(1, 1, At, B1); PG8_BAR;
            }
        }
        if constexpr (ALIGN_EPI) { if (wr == 0) PG8_BAR; }
        if constexpr (!Epi::AFTER_DRAIN) { E(acc, cur, wr, wc, fr, fq); S.done(cur); }
        if (!has_next) break;
#pragma unroll
        for (int a = 0; a < 2; ++a)
#pragma unroll
            for (int b = 0; b < 2; ++b)
#pragma unroll
                for (int m = 0; m < 4; ++m)
#pragma unroll
                    for (int n = 0; n < 2; ++n) acc[a][b][m][n] = (f32x4){0.f, 0.f, 0.f, 0.f};
        cur = nxt; cA = nA; cB = nB; ++ui;
        if constexpr (ALIGN_EPI) { if (wr == 1) PG8_BAR; }
    }
    PG8_WAIT_V(0);
    if constexpr (!ALIGN_EPI) { if (wr == 0) PG8_BAR; }
    PG8_BAR;
    if constexpr (Epi::AFTER_DRAIN) { E.fused(acc, cur, wr, wc, fr, fq, lds, wid, lane); S.done(cur); }
#undef PG8_SA
#undef PG8_SB
#undef PG8_STAGE
#undef PG8_LDA
#undef PG8_LDB
#undef PG8_MMA
#undef PG8_WAIT_V
#undef PG8_WAIT_L
#undef PG8_BAR
#undef PG8_SCHED
}
}

#include <hip/hip_cooperative_groups.h>
namespace cg = cooperative_groups;
#define LAS __attribute__((address_space(3)))
typedef unsigned short bf16_t;
typedef short bf16x8 __attribute__((ext_vector_type(8)));
typedef short s16x4 __attribute__((ext_vector_type(4)));
typedef float f32x4 __attribute__((ext_vector_type(4)));
typedef float f32x16 __attribute__((ext_vector_type(16)));
typedef unsigned u32x4 __attribute__((ext_vector_type(4)));
typedef unsigned u32x2 __attribute__((ext_vector_type(2)));
using pg8::bf2f; using pg8::bflo; using pg8::bfhi; using pg8::silu_f; using pg8::gelu_tanh_f; using pg8::cvt_pk_bf16;

constexpr int MROWS = 16384, SEQL = 4096, DM = 2048;
constexpr size_t MiB = 1u << 20;
constexpr size_t WS_ROPE = 1 * MiB;
constexpr size_t WS_AT = WS_ROPE + 512 * 1024;
constexpr size_t WS_S5 = 2 * MiB;
constexpr size_t WS_W = 34 * MiB;
constexpr size_t W_INE = 0, W_GLU = 20 * MiB, W_OUTE = 22 * MiB, W_INO = 30 * MiB, W_OUTO = 62 * MiB, W_PER = 70 * MiB;
constexpr size_t WS_XN = 174 * MiB;
constexpr size_t WS_PROJ = 238 * MiB;
constexpr size_t WS_YAP = WS_PROJ + 160 * MiB;
constexpr size_t WS_END = 494 * MiB;
constexpr int SUBLN_OFF = 147456;
constexpr int LDS_BYTES = 147456 + 1024 + 256;

__device__ __forceinline__ float wave_sum(float v) {
#pragma unroll
    for (int o = 1; o < 64; o <<= 1) v += __shfl_xor(v, o);
    return v;
}
__device__ __forceinline__ f32x16 mfma32(bf16x8 a, bf16x8 b, f32x16 c) { return __builtin_amdgcn_mfma_f32_32x32x16_bf16(a, b, c, 0, 0, 0); }
__device__ __forceinline__ s16x4 lds_tr(const LAS unsigned char* p) {
    return __builtin_bit_cast(s16x4, __builtin_amdgcn_ds_read_tr16_b64_v4i16((LAS s16x4*)p));
}
__device__ __forceinline__ bf16x8 pack8(const float* v) {
    u32x4 w; w.x = cvt_pk_bf16(v[0], v[1]); w.y = cvt_pk_bf16(v[2], v[3]); w.z = cvt_pk_bf16(v[4], v[5]); w.w = cvt_pk_bf16(v[6], v[7]);
    return __builtin_bit_cast(bf16x8, w);
}
__device__ __forceinline__ void sincos_red(double x, float& s, float& c) {
    const double k = rint(x * 0.15915494309189535);
    const float r = (float)(x - k * 6.283185307179586);
    s = __sinf(r); c = __cosf(r);
}

__device__ __forceinline__ void transpose_item(const float* __restrict__ W, int K, int N, bf16_t* __restrict__ WT, float* scr, int item, int lane, const float* gk = nullptr) {
    const int nblk = N / 32, kb = item / nblk, nb = item % nblk, k0 = 64 * kb, n0 = 32 * nb;
    f32x4 v[8];
#pragma unroll
    for (int i = 0; i < 8; ++i) { v[i] = *(const f32x4*)(W + (size_t)(k0 + 8 * i + (lane >> 3)) * N + n0 + 4 * (lane & 7)); if (gk) v[i] = v[i] * gk[k0 + 8 * i + (lane >> 3)]; }
#pragma unroll
    for (int i = 0; i < 8; ++i) { float* d = scr + (8 * i + (lane >> 3)) * 33 + 4 * (lane & 7); d[0] = v[i][0]; d[1] = v[i][1]; d[2] = v[i][2]; d[3] = v[i][3]; }
    asm volatile("s_waitcnt lgkmcnt(0)" ::: "memory");
    const int c = lane & 7;
#pragma unroll
    for (int j = 0; j < 4; ++j) { const int n = (lane >> 3) + 8 * j; const float* s = scr + (8 * c) * 33 + n;
        u32x4 o; o.x = cvt_pk_bf16(s[0 * 33], s[1 * 33]); o.y = cvt_pk_bf16(s[2 * 33], s[3 * 33]); o.z = cvt_pk_bf16(s[4 * 33], s[5 * 33]); o.w = cvt_pk_bf16(s[6 * 33], s[7 * 33]);
        *(u32x4*)(WT + (size_t)(n0 + n) * K + k0 + 8 * c) = o; }
    asm volatile("s_waitcnt lgkmcnt(0)" ::: "memory");
}
__device__ __forceinline__ void transpose_block(const float* __restrict__ W, int K, int N, bf16_t* __restrict__ WT, float* scr, int item, int tid, const float* gk) {
    const int nblk = N / 256, kb = item / nblk, nb = item % nblk, k0 = 64 * kb, n0 = 256 * nb;
    f32x4 v[8];
#pragma unroll
    for (int i = 0; i < 8; ++i) { const int idx = tid + 512 * i, row = idx >> 6, c4 = idx & 63; v[i] = *(const f32x4*)(W + (size_t)(k0 + row) * N + n0 + 4 * c4); }
    if (gk) {
        float gv[8];
#pragma unroll
        for (int i = 0; i < 8; ++i) gv[i] = gk[k0 + ((tid + 512 * i) >> 6)];
#pragma unroll
        for (int i = 0; i < 8; ++i) v[i] = v[i] * gv[i];
    }
#pragma unroll
    for (int i = 0; i < 8; ++i) { const int idx = tid + 512 * i, row = idx >> 6, c4 = idx & 63; float* d = scr + row * 257 + 4 * c4; d[0] = v[i][0]; d[1] = v[i][1]; d[2] = v[i][2]; d[3] = v[i][3]; }
    __syncthreads();
#pragma unroll
    for (int j = 0; j < 4; ++j) { const int idx = tid + 512 * j, n = idx >> 3, c = idx & 7; const float* sp = scr + (8 * c) * 257 + n;
        u32x4 o; o.x = cvt_pk_bf16(sp[0 * 257], sp[1 * 257]); o.y = cvt_pk_bf16(sp[2 * 257], sp[3 * 257]); o.z = cvt_pk_bf16(sp[4 * 257], sp[5 * 257]); o.w = cvt_pk_bf16(sp[6 * 257], sp[7 * 257]);
        *(u32x4*)(WT + (size_t)(n0 + n) * K + k0 + 8 * c) = o; }
    __syncthreads();
}

template <bool FINAL> __device__ __forceinline__ void rms_row(const float* xrow, const float* g, bf16_t* obf, float* of32, int lane) {
    const f32x4* xr = (const f32x4*)xrow + lane; const f32x4* gr = (const f32x4*)g + lane;
    f32x4 v[8], gg[8]; float s = 0.f;
#pragma unroll
    for (int j = 0; j < 8; ++j) { v[j] = xr[64 * j]; gg[j] = gr[64 * j]; }
#pragma unroll
    for (int j = 0; j < 8; ++j) s += (v[j].x * v[j].x + v[j].y * v[j].y) + (v[j].z * v[j].z + v[j].w * v[j].w);
    const float rstd = rsqrtf(wave_sum(s) * (1.f / 2048.f) + 1e-6f);
#pragma unroll
    for (int j = 0; j < 8; ++j) { const f32x4 o = v[j] * rstd * gg[j];
        if (FINAL) ((f32x4*)of32)[64 * j + lane] = o;
        else { u32x2 w; w.x = cvt_pk_bf16(o.x, o.y); w.y = cvt_pk_bf16(o.z, o.w); ((u32x2*)obf)[64 * j + lane] = w; } }
}
__device__ __forceinline__ void rms_rows4_final(float* x, int m0, int step, const float* g, int lane) {
    f32x4 v[4][8], gg[8]; float s[4];
#pragma unroll
    for (int r = 0; r < 4; ++r)
#pragma unroll
        for (int j = 0; j < 8; ++j) v[r][j] = ((const f32x4*)(x + (size_t)(m0 + r * step) * DM))[64 * j + lane];
#pragma unroll
    for (int j = 0; j < 8; ++j) gg[j] = ((const f32x4*)g)[64 * j + lane];
#pragma unroll
    for (int r = 0; r < 4; ++r) { float a = 0.f;
#pragma unroll
        for (int j = 0; j < 8; ++j) a += (v[r][j].x * v[r][j].x + v[r][j].y * v[r][j].y) + (v[r][j].z * v[r][j].z + v[r][j].w * v[r][j].w);
        s[r] = a; }
#pragma unroll
    for (int o = 1; o < 64; o <<= 1)
#pragma unroll
        for (int r = 0; r < 4; ++r) s[r] += __shfl_xor(s[r], o);
#pragma unroll
    for (int r = 0; r < 4; ++r) { const float rstd = rsqrtf(s[r] * (1.f / 2048.f) + 1e-6f);
#pragma unroll
        for (int j = 0; j < 8; ++j) ((f32x4*)(x + (size_t)(m0 + r * step) * DM))[64 * j + lane] = v[r][j] * rstd * gg[j]; }
}

__device__ __forceinline__ void xb_row(const float* xrow, bf16_t* obf, float* ssq, int lane) {
    const f32x4* xr = (const f32x4*)xrow + lane; float s = 0.f;
    f32x4 v[8];
#pragma unroll
    for (int j = 0; j < 8; ++j) v[j] = xr[64 * j];
#pragma unroll
    for (int j = 0; j < 8; ++j) { s += (v[j].x * v[j].x + v[j].y * v[j].y) + (v[j].z * v[j].z + v[j].w * v[j].w);
        u32x2 w; w.x = cvt_pk_bf16(v[j].x, v[j].y); w.y = cvt_pk_bf16(v[j].z, v[j].w); ((u32x2*)obf)[64 * j + lane] = w; }
    s = wave_sum(s);
    if (lane == 0) *ssq = s;
}

__device__ __forceinline__ void xb_rows4(const float* x, bf16_t* xb, float* ssq, int m0, int step, int lane) {
    f32x4 v[4][8]; float s[4];
#pragma unroll
    for (int r = 0; r < 4; ++r)
#pragma unroll
        for (int j = 0; j < 8; ++j) v[r][j] = ((const f32x4*)(x + (size_t)(m0 + r * step) * DM))[64 * j + lane];
#pragma unroll
    for (int r = 0; r < 4; ++r) { float a = 0.f;
#pragma unroll
        for (int j = 0; j < 8; ++j) { a += (v[r][j].x * v[r][j].x + v[r][j].y * v[r][j].y) + (v[r][j].z * v[r][j].z + v[r][j].w * v[r][j].w);
            u32x2 w; w.x = cvt_pk_bf16(v[r][j].x, v[r][j].y); w.y = cvt_pk_bf16(v[r][j].z, v[r][j].w); ((u32x2*)(xb + (size_t)(m0 + r * step) * DM))[64 * j + lane] = w; }
        s[r] = a; }
#pragma unroll
    for (int o = 1; o < 64; o <<= 1)
#pragma unroll
        for (int r = 0; r < 4; ++r) s[r] += __shfl_xor(s[r], o);
    if (lane == 0) {
#pragma unroll
        for (int r = 0; r < 4; ++r) ssq[m0 + r * step] = s[r]; }
}

__device__ __forceinline__ void s5_tables(int jl, int g, const float* lam_re, const float* lam_im, const float* log_dt, const float* b_re, const float* b_im,
                                          const float* c_re, const float* c_im, const float* d_skip, unsigned char* ws, float* L, int tid) {
    float* are = L;
    float* aim = L + 1088;
    float* bbr = L + 2176;
    float* bbi = L + 3200;
    float* cr = L + 4224;
    float* ci = L + 5248;
    float* Kl = L + 6272;
    float* fre = L + 10368;
    float* fim = L + 10432;
    const int combo = jl * 64 + g;
    if (tid < 64) {
        const int p = tid;
        const float dt = expf(log_dt[combo]); const float lr = lam_re[combo * 64 + p], li = lam_im[combo * 64 + p];
        const double xr = (double)lr * (double)dt, xi = (double)li * (double)dt;
        for (int t = 0; t <= 16; ++t) { float s, c; sincos_red(xi * t, s, c); const float mag = expf((float)(xr * t)); are[t * 64 + p] = mag * c; aim[t * 64 + p] = mag * s; }
        float s1, c1, sh, chh; sincos_red(xi, s1, c1); sincos_red(xi * 0.5, sh, chh);
        const float em1 = expm1f((float)xr); const float mag1 = em1 + 1.f;
        const float nr = em1 * c1 - 2.f * sh * sh, abi = mag1 * s1;
        const float den = lr * lr + li * li;
        fre[p] = (nr * lr + abi * li) / den; fim[p] = (abi * lr - nr * li) / den;
    }
    __syncthreads();
    for (int i = tid; i < 1024; i += 512) {
        const int p = i >> 4; const float br = b_re[combo * 1024 + i], bi = b_im[combo * 1024 + i];
        bbr[i] = fre[p] * br - fim[p] * bi; bbi[i] = fre[p] * bi + fim[p] * br;
        cr[i] = c_re[combo * 1024 + i]; ci[i] = c_im[combo * 1024 + i];
    }
    __syncthreads();
    {
        const int th = tid >> 1, tau = th >> 4, h = th & 15, hb = (tid & 1) * 8;
        float k[8];
#pragma unroll
        for (int e = 0; e < 8; ++e) k[e] = 0.f;
        for (int p = 0; p < 64; ++p) {
            const float c_r = cr[h * 64 + p], c_i = ci[h * 64 + p], a_r = are[tau * 64 + p], a_i = aim[tau * 64 + p];
            const float gr = c_r * a_r - c_i * a_i, gi = c_r * a_i + c_i * a_r;
#pragma unroll
            for (int e = 0; e < 8; ++e) k[e] += gr * bbr[p * 16 + hb + e] - gi * bbi[p * 16 + hb + e];
        }
#pragma unroll
        for (int e = 0; e < 8; ++e) { float v = k[e]; if (tau == 0 && h == hb + e) v += d_skip[jl * 1024 + g * 16 + h]; Kl[tau * 256 + h * 16 + hb + e] = v; }
    }
    __syncthreads();
    unsigned* Kt = (unsigned*)(ws + WS_S5 + (size_t)combo * 262144);
    unsigned* E = Kt + 32768; unsigned* F = E + 16384;
    for (int i = tid; i < 32768; i += 512) {
        const int o = i >> 7, k = (i & 127) * 2, t = o >> 4, h = o & 15, s = k >> 4, hp = k & 15;
        float v0 = 0.f, v1 = 0.f;
        if (s <= t) { v0 = Kl[(t - s) * 256 + h * 16 + hp]; v1 = Kl[(t - s) * 256 + h * 16 + hp + 1]; }
        Kt[i] = cvt_pk_bf16(v0, v1);
    }
    for (int i = tid; i < 16384; i += 512) {
        const int e = i >> 7, k = (i & 127) * 2, s = k >> 4, hp = k & 15, p = e & 63;
        const float a_r = are[(15 - s) * 64 + p], a_i = aim[(15 - s) * 64 + p];
        float v0, v1;
        if (e < 64) { v0 = a_r * bbr[p * 16 + hp] - a_i * bbi[p * 16 + hp]; v1 = a_r * bbr[p * 16 + hp + 1] - a_i * bbi[p * 16 + hp + 1]; }
        else { v0 = a_r * bbi[p * 16 + hp] + a_i * bbr[p * 16 + hp]; v1 = a_r * bbi[p * 16 + hp + 1] + a_i * bbr[p * 16 + hp + 1]; }
        E[i] = cvt_pk_bf16(v0, v1);
    }
    for (int i = tid; i < 16384; i += 512) {
        const int o = i >> 6, e = (i & 63) * 2, t = o >> 4, h = o & 15;
        float v[2];
#pragma unroll
        for (int q = 0; q < 2; ++q) { const int ee = e + q, p = ee & 63; const float c_r = cr[h * 64 + p], c_i = ci[h * 64 + p], a_r = are[(t + 1) * 64 + p], a_i = aim[(t + 1) * 64 + p];
            v[q] = (ee < 64) ? (c_r * a_r - c_i * a_i) : -(c_r * a_i + c_i * a_r); }
        F[i] = cvt_pk_bf16(v[0], v[1]);
    }
    float* AT = (float*)(ws + WS_AT) + combo * 128;
    if (tid < 64) { AT[tid] = are[16 * 64 + tid]; AT[64 + tid] = aim[16 * 64 + tid]; }
    __syncthreads();
}

__device__ __forceinline__ void s5_item(int b, int g, const unsigned char* tab, const float* AT, const bf16_t* proj, bf16_t* yap, unsigned char* lds, int tid) {
    const int w = __builtin_amdgcn_readfirstlane(tid >> 6);
    constexpr int ZS = 132;
#define RELANE() int tl_ = tid; asm volatile("" : "+v"(tl_)); const int lane = tl_ & 63, n32 = lane & 31, hl = lane >> 5; (void)lane; (void)n32; (void)hl;
    float* Z = (float*)lds;
    const bf16_t* Kt = (const bf16_t*)tab; const bf16_t* E = Kt + 65536; const bf16_t* F = E + 32768;
    bf16x8 uf[16];
    { RELANE();
    const size_t rowbase = (size_t)b * SEQL + 16 * (32 * w + n32);
#pragma unroll
    for (int s = 0; s < 16; ++s) uf[s] = *(const bf16x8*)(proj + ((size_t)(b * 64 + g) * 4096 + 16 * (32 * w + n32) + s) * 16 + 8 * hl);
    }
#pragma unroll
    for (int eb = 0; eb < 4; ++eb) {
        RELANE();
        f32x16 acc;
#pragma unroll
        for (int r = 0; r < 16; ++r) acc[r] = 0.f;
#pragma unroll
        for (int sb = 0; sb < 2; ++sb) {
            bf16x8 bq[8];
#pragma unroll
            for (int i = 0; i < 8; ++i) bq[i] = *(const bf16x8*)(E + (32 * eb + n32) * 256 + 16 * (8 * sb + i) + 8 * hl);
            __builtin_amdgcn_sched_barrier(0);
#pragma unroll
            for (int i = 0; i < 8; ++i) acc = mfma32(uf[8 * sb + i], bq[i], acc);
            __builtin_amdgcn_sched_barrier(0);
        }
#pragma unroll
        for (int r = 0; r < 16; ++r) { const int c = (r & 3) + 8 * (r >> 2) + 4 * hl; Z[(32 * w + c) * ZS + 32 * eb + n32] = acc[r]; }
    }
    __syncthreads();
    if (w == 0) {
        RELANE();
        const float ar = AT[lane], ai = AT[64 + lane]; float sr = 0.f, si = 0.f;
#pragma unroll 8
        for (int c = 0; c < 256; ++c) { const float zr = Z[c * ZS + lane], zi = Z[c * ZS + 64 + lane]; Z[c * ZS + lane] = sr; Z[c * ZS + 64 + lane] = si;
            const float nr = ar * sr - ai * si + zr, ni = ar * si + ai * sr + zi; sr = nr; si = ni; }
    }
    __syncthreads();
    bf16x8 sf[8];
#pragma unroll
    for (int s = 0; s < 8; ++s) { RELANE(); const float* zp = Z + (32 * w + n32) * ZS + 16 * s + 8 * hl; const f32x4 a = *(const f32x4*)zp, bq = *(const f32x4*)(zp + 4);
        float t8[8] = {a[0], a[1], a[2], a[3], bq[0], bq[1], bq[2], bq[3]}; sf[s] = pack8(t8); }
#pragma unroll
    for (int ob = 0; ob < 8; ++ob) {
        RELANE();
        f32x16 acc;
#pragma unroll
        for (int r = 0; r < 16; ++r) acc[r] = 0.f;
        {
            const int nk = 2 * ob + 2, total = nk + 8;
#define S5_LDB(i) (((i) < nk) ? *(const bf16x8*)(Kt + (32 * ob + n32) * 256 + 16 * (i) + 8 * hl) : *(const bf16x8*)(F + (32 * ob + n32) * 128 + 16 * ((i) - nk) + 8 * hl))
#define S5_AFR(i) (((i) < nk) ? uf[(i) < nk ? (i) : 0] : sf[(i) < nk ? 0 : (i) - nk])
            bf16x8 cur[8], nxt[8];
#pragma unroll
            for (int i = 0; i < 8; ++i) cur[i] = S5_LDB(i);
#pragma unroll
            for (int b0 = 0; b0 < total; b0 += 8) {
#pragma unroll
                for (int i = 0; i < 8; ++i) nxt[i] = (b0 + 8 + i < total) ? S5_LDB(b0 + 8 + i) : cur[i];
                __builtin_amdgcn_sched_barrier(0);
#pragma unroll
                for (int i = 0; i < 8; ++i) if (b0 + i < total) acc = mfma32(S5_AFR(b0 + i), cur[i], acc);
                __builtin_amdgcn_sched_barrier(0);
#pragma unroll
                for (int i = 0; i < 8; ++i) cur[i] = nxt[i];
            }
#undef S5_LDB
#undef S5_AFR
        }
        const int t = 2 * ob + (n32 >> 4), hh = n32 & 15;
#pragma unroll
        for (int r = 0; r < 16; ++r) { const int c = (r & 3) + 8 * (r >> 2) + 4 * hl; const size_t pos = (size_t)b * SEQL + 16 * (32 * w + c) + t;
            yap[pos * 1024 + g * 16 + hh] = (bf16_t)(cvt_pk_bf16(gelu_tanh_f(acc[r]), 0.f) & 0xffffu); }
        asm volatile("" ::: "memory");
    }
    __syncthreads();
#undef RELANE
}

__device__ __forceinline__ void sgu_item(int b, int nc, int gh, const bf16_t* proj, bf16_t* mix, const float* ln_g, const float* ln_b, const bf16_t* wspb  , const float* b_sp,
                                         unsigned char* lds, int tid) {
    const int w = __builtin_amdgcn_readfirstlane(tid >> 6);
#define RELANE() int tl_ = tid; asm volatile("" : "+v"(tl_)); const int lane = tl_ & 63, n32 = lane & 31, hl = lane >> 5; (void)lane; (void)n32; (void)hl;
    float* stat = (float*)lds; unsigned char* Vn = lds + 1024; constexpr int VS = 320;
    const size_t row0 = (size_t)b * SEQL + nc * 128;
#pragma unroll
    for (int hb = 0; hb < 2; ++hb) {
        RELANE();
        u32x4 a[8], c[8];
#pragma unroll
        for (int i = 0; i < 8; ++i) { const bf16_t* vp = proj + (row0 + 16 * w + 8 * hb + i) * 5120 + 3072 + lane * 16; a[i] = *(const u32x4*)vp; c[i] = *(const u32x4*)(vp + 8); }
        float sm[8], sq[8];
#pragma unroll
        for (int i = 0; i < 8; ++i) {
            const float x[16] = {bflo(a[i].x), bfhi(a[i].x), bflo(a[i].y), bfhi(a[i].y), bflo(a[i].z), bfhi(a[i].z), bflo(a[i].w), bfhi(a[i].w), bflo(c[i].x), bfhi(c[i].x), bflo(c[i].y), bfhi(c[i].y), bflo(c[i].z), bfhi(c[i].z), bflo(c[i].w), bfhi(c[i].w)};
            float s1 = 0.f, s2 = 0.f;
#pragma unroll
            for (int e = 0; e < 16; ++e) { s1 += x[e]; s2 += x[e] * x[e]; }
            sm[i] = s1; sq[i] = s2;
        }
#pragma unroll
        for (int o = 1; o < 64; o <<= 1)
#pragma unroll
            for (int i = 0; i < 8; ++i) { sm[i] += __shfl_xor(sm[i], o); sq[i] += __shfl_xor(sq[i], o); }
#pragma unroll
        for (int i = 0; i < 8; ++i) { const float mean = sm[i] * (1.f / 1024.f); const float var = fmaxf(sq[i] * (1.f / 1024.f) - mean * mean, 0.f);
            if (lane == 0) { const int s = 16 * w + 8 * hb + i; stat[2 * s] = mean; stat[2 * s + 1] = rsqrtf(var + 1e-5f); } }
    }
    __syncthreads();
    for (int gi = 0; gi < 4; ++gi) {
        const int g = 4 * gh + gi;
        const int tb = w >> 1, cb0 = 2 * (w & 1);
        bf16x8 afr[8];
        {
            RELANE();
            const bf16_t* wp = wspb + ((size_t)g * 128 + 32 * tb + n32) * 128 + 8 * hl;
#pragma unroll
            for (int ks = 0; ks < 8; ++ks) afr[ks] = *(const bf16x8*)(wp + 16 * ks);
            const int ch = tl_ & 15, sb = tl_ >> 4;
            u32x4 av[4];
#pragma unroll
            for (int i = 0; i < 4; ++i) av[i] = *(const u32x4*)(proj + (row0 + sb + 32 * i) * 5120 + 3072 + g * 128 + 8 * ch);
            const f32x4 g0 = *(const f32x4*)(ln_g + g * 128 + 8 * ch), g1 = *(const f32x4*)(ln_g + g * 128 + 8 * ch + 4);
            const f32x4 b0 = *(const f32x4*)(ln_b + g * 128 + 8 * ch), b1 = *(const f32x4*)(ln_b + g * 128 + 8 * ch + 4);
#pragma unroll
            for (int i = 0; i < 4; ++i) {
                const int s = sb + 32 * i; const u32x4 a = av[i];
                const float mean = stat[2 * s], rstd = stat[2 * s + 1];
                float o[8];
                o[0] = (bflo(a.x) - mean) * rstd * g0[0] + b0[0]; o[1] = (bfhi(a.x) - mean) * rstd * g0[1] + b0[1];
                o[2] = (bflo(a.y) - mean) * rstd * g0[2] + b0[2]; o[3] = (bfhi(a.y) - mean) * rstd * g0[3] + b0[3];
                o[4] = (bflo(a.z) - mean) * rstd * g1[0] + b1[0]; o[5] = (bfhi(a.z) - mean) * rstd * g1[1] + b1[1];
                o[6] = (bflo(a.w) - mean) * rstd * g1[2] + b1[2]; o[7] = (bfhi(a.w) - mean) * rstd * g1[3] + b1[3];
                *(bf16x8*)(Vn + s * VS + ch * 16) = pack8(o);
            }
        }
        __syncthreads();
        f32x16 acc0, acc1;
#pragma unroll
        for (int r = 0; r < 16; ++r) { acc0[r] = 0.f; acc1[r] = 0.f; }
        {
            RELANE();
            const int q4 = (lane & 15) >> 2, p4 = lane & 3, cpart = 16 * ((lane >> 4) & 1) + 4 * p4;
#pragma unroll
            for (int ks = 0; ks < 8; ++ks) {
                if (ks >= 2 * tb + 2) continue;
                const LAS unsigned char* vb = (const LAS unsigned char*)Vn + (16 * ks + 8 * hl + q4) * VS + cpart * 2;
                const s16x4 l0 = lds_tr(vb + (32 * cb0) * 2), h0 = lds_tr(vb + 4 * VS + (32 * cb0) * 2);
                const s16x4 l1 = lds_tr(vb + (32 * cb0 + 32) * 2), h1 = lds_tr(vb + 4 * VS + (32 * cb0 + 32) * 2);
                const bf16x8 bf0 = {l0[0], l0[1], l0[2], l0[3], h0[0], h0[1], h0[2], h0[3]};
                const bf16x8 bf1 = {l1[0], l1[1], l1[2], l1[3], h1[0], h1[1], h1[2], h1[3]};
                acc0 = mfma32(afr[ks], bf0, acc0); acc1 = mfma32(afr[ks], bf1, acc1);
            }
        }
        {
            float* So = (float*)(lds + 1024 + 128 * VS);
#pragma unroll
            for (int cc = 0; cc < 2; ++cc) {
                RELANE();
                const int c = 32 * (cb0 + cc) + n32;
#pragma unroll
                for (int r = 0; r < 16; ++r) { const int t = 32 * tb + (r & 3) + 8 * (r >> 2) + 4 * hl;
                    So[t * 132 + c] = (cc == 0 ? acc0[r] : acc1[r]) + b_sp[g * 128 + t]; }
            }
            __syncthreads();
            {
                RELANE();
                const int ch = tl_ & 15, tbs = tl_ >> 4;
                u32x4 u8[4], g8[4];
#pragma unroll
                for (int i = 0; i < 4; ++i) { const size_t row = row0 + tbs + 32 * i;
                    u8[i] = *(const u32x4*)(proj + row * 5120 + 2048 + g * 128 + 8 * ch); g8[i] = *(const u32x4*)(proj + row * 5120 + 4096 + g * 128 + 8 * ch); }
#pragma unroll
                for (int i = 0; i < 4; ++i) {
                    const int t = tbs + 32 * i; const size_t row = row0 + t;
                    const f32x4 s0 = *(const f32x4*)(So + t * 132 + 8 * ch), s1 = *(const f32x4*)(So + t * 132 + 8 * ch + 4);
                    u32x4 o;
                    o.x = cvt_pk_bf16(bflo(u8[i].x) * s0[0] * bflo(g8[i].x), bfhi(u8[i].x) * s0[1] * bfhi(g8[i].x));
                    o.y = cvt_pk_bf16(bflo(u8[i].y) * s0[2] * bflo(g8[i].y), bfhi(u8[i].y) * s0[3] * bfhi(g8[i].y));
                    o.z = cvt_pk_bf16(bflo(u8[i].z) * s1[0] * bflo(g8[i].z), bfhi(u8[i].z) * s1[1] * bfhi(g8[i].z));
                    o.w = cvt_pk_bf16(bflo(u8[i].w) * s1[2] * bflo(g8[i].w), bfhi(u8[i].w) * s1[3] * bfhi(g8[i].w));
                    *(u32x4*)((bf16_t*)proj + row * 5120 + 2048 + g * 128 + 8 * ch) = o;
                }
            }
        }
        __syncthreads();
    }
#undef RELANE
}

constexpr int AK_BYTES = 16384, AV_BYTES = 32768, AV_OFF = 3 * AK_BYTES;
__device__ __forceinline__ void glds16(const void* gsrc, unsigned lds_dst) {
    unsigned keep;
    asm volatile("s_mov_b32 %0, m0\n\ts_mov_b32 m0, %2\n\ts_nop 0\n\tglobal_load_lds_dwordx4 %1, off\n\ts_mov_b32 m0, %0" : "=&s"(keep) : "v"(gsrc), "s"(lds_dst) : "memory");
}
struct DmaOff { unsigned k[2], v[4]; };
__device__ __forceinline__ DmaOff attn_dma_off(int w, int tl) {
    DmaOff o; const int lane = tl & 63;
#pragma unroll
    for (int i = 0; i < 2; ++i) { const int key = 8 * w + 4 * i + (lane >> 4), c = (lane & 15) ^ (key & 15); o.k[i] = (unsigned)key * 16384u + (unsigned)c * 16u; }
#pragma unroll
    for (int i = 0; i < 4; ++i) { const int key = 8 * w + 2 * i + (lane >> 5), c = (lane & 31) ^ ((key & 3) << 2); o.v[i] = (unsigned)key * 16384u + (unsigned)c * 16u; }
    return o;
}
__device__ __forceinline__ void attn_dma(const char* kb_t, const char* vb_t, unsigned char* lds, int bb, int w, const DmaOff& o) {
    const unsigned l0 = (unsigned)(uintptr_t)lds;
#pragma unroll
    for (int i = 0; i < 2; ++i) glds16(kb_t + (size_t)o.k[i], (unsigned)__builtin_amdgcn_readfirstlane(l0 + bb * AK_BYTES + (2 * w + i) * 1024));
#pragma unroll
    for (int i = 0; i < 4; ++i) glds16(vb_t + (size_t)o.v[i], (unsigned)__builtin_amdgcn_readfirstlane(l0 + AV_OFF + bb * AV_BYTES + (4 * w + i) * 1024));
}
__device__ __forceinline__ void attn_unit(int b, int h, int qblk, const bf16_t* proj, bf16_t* mix, float lam, const float* subln, float oscale, unsigned char* lds, int tid_in) {
    const int w = __builtin_amdgcn_readfirstlane(tid_in >> 6);
    const int q0 = qblk * 256;
    const int NT = 4 * qblk + 4;
    const int wq_lo = q0 + 32 * w, wq_hi = wq_lo + 31;
    f32x16 O[8];
#pragma unroll
    for (int j = 0; j < 2; ++j) {
        __builtin_amdgcn_sched_barrier(0);
        bf16x8 qf[8]; DmaOff dmo; int kofs[8];
        const char* kbase = (const char*)(proj + (size_t)b * SEQL * 8192 + 2048 + h * 256 + j * 128);
        const char* vbase = (const char*)(proj + (size_t)b * SEQL * 8192 + 4096 + h * 256);
        {
            int tl = tid_in; asm volatile("" : "+v"(tl));
            dmo = attn_dma_off(w, tl);
            attn_dma(kbase, vbase, lds, 0, w, dmo);
            attn_dma(kbase + (size_t)64 * 16384, vbase + (size_t)64 * 16384, lds, 1, w, dmo);
            { const int n32_ = tl & 31, hl_ = (tl >> 5) & 1; const int u4_ = (hl_ ^ (n32_ & 15)) << 4;
#pragma unroll
              for (int i = 0; i < 8; ++i) kofs[i] = n32_ * 256 + ((i * 32) ^ u4_); }
            const int lane = tl & 63, n32 = lane & 31, hl = lane >> 5;
            const size_t grow = (size_t)b * SEQL + q0 + 32 * w + n32;
#pragma unroll
            for (int d0 = 0; d0 < 8; ++d0) qf[d0] = *(const bf16x8*)(proj + grow * 8192 + h * 256 + j * 128 + 16 * d0 + 8 * hl);
        }
#pragma unroll
        for (int vb = 0; vb < 8; ++vb)
#pragma unroll
            for (int r = 0; r < 16; ++r) O[vb][r] = 0.f;
        float mrun = -1e30f, lrun = 0.f;
#pragma unroll
        for (int d0 = 0; d0 < 8; ++d0) asm volatile("" : "+v"(qf[d0]));
        asm volatile("s_waitcnt vmcnt(0)" ::: "memory");
        __syncthreads();
        int bb = 0;
        for (int t = 0; t < NT; ++t) {
            int tid = tid_in; asm volatile("" : "+v"(tid));
            const int b2 = (bb == 0) ? 2 : bb - 1;
            if (t + 2 < NT) attn_dma(kbase + (size_t)(t + 2) * 64 * 16384, vbase + (size_t)(t + 2) * 64 * 16384, lds, b2, w, dmo);
            if (64 * t <= wq_hi) {
                const int lane = tid & 63, n32 = lane & 31, hl = lane >> 5;
                const int q4 = (lane & 15) >> 2, cpart = 16 * ((lane >> 4) & 1) + 4 * (lane & 3);
                const int qrow = q0 + 32 * w + n32;
                const LAS unsigned char* Kb = (const LAS unsigned char*)lds + bb * AK_BYTES;
                const int u4 = (hl ^ (n32 & 15)) << 4;
                const LAS unsigned char* Vb = (const LAS unsigned char*)lds + AV_OFF + bb * AV_BYTES + (4 * hl + q4) * 512 + 2 * cpart;
                const int vs0 = (0 ^ q4) << 6, vs1 = (1 ^ q4) << 6, vs2 = (2 ^ q4) << 6, vs3 = (3 ^ q4) << 6;
#pragma unroll
                for (int sub = 0; sub < 2; ++sub) {
                    if (64 * t + 32 * sub <= wq_hi) {
                        f32x16 S;
#pragma unroll
                        for (int r = 0; r < 16; ++r) S[r] = 0.f;
#pragma unroll
                        for (int dg = 0; dg < 2; ++dg) {
                            bf16x8 ka[4];
#pragma unroll
                            for (int i = 0; i < 4; ++i) ka[i] = *(const LAS bf16x8*)(Kb + sub * 8192 + kofs[4 * dg + i]);
#pragma unroll
                            for (int i = 0; i < 4; ++i) S = mfma32(ka[i], qf[4 * dg + i], S);
                        }
                        if (64 * t + 32 * sub + 31 > wq_lo) {
#pragma unroll
                            for (int r = 0; r < 16; ++r) { const int kidx = 64 * t + 32 * sub + (r & 3) + 8 * (r >> 2) + 4 * hl; if (kidx > qrow) S[r] = -INFINITY; }
                        }
                        float mx = fmaxf(S[0], S[1]);
#pragma unroll
                        for (int r = 2; r < 16; ++r) mx = fmaxf(mx, S[r]);
                        mx = fmaxf(mx, __shfl_xor(mx, 32));
                        if (__any(mx > mrun + 8.f)) {
                            const float mnew = fmaxf(mrun, mx); const float alpha = __builtin_amdgcn_exp2f(mrun - mnew);
                            lrun *= alpha; mrun = mnew;
#pragma unroll
                            for (int vb = 0; vb < 8; ++vb)
#pragma unroll
                                for (int r = 0; r < 16; ++r) O[vb][r] *= alpha;
                        }
                        float ls = 0.f;
#pragma unroll
                        for (int r = 0; r < 16; ++r) { S[r] = __builtin_amdgcn_exp2f(S[r] - mrun); ls += S[r]; }
                        lrun += ls;
                        bf16x8 pf[2];
                        { float t8[8];
#pragma unroll
                          for (int s = 0; s < 2; ++s) {
#pragma unroll
                              for (int e = 0; e < 8; ++e) t8[e] = S[8 * s + e];
                              pf[s] = pack8(t8); } }
                        {
                            const LAS unsigned char* vrow = Vb + (32 * sub) * 512;
#define VLD(dst, g_) do { _Pragma("unroll") for (int i_ = 0; i_ < 4; ++i_) { const int s_ = (g_) >> 1, vb_ = 4 * ((g_) & 1) + i_; \
        const int vs_ = (i_ == 0) ? vs0 : (i_ == 1) ? vs1 : (i_ == 2) ? vs2 : vs3; \
        dst[2 * i_] = lds_tr(vrow + s_ * 16 * 512 + vs_ + (vb_ >> 2) * 256); dst[2 * i_ + 1] = lds_tr(vrow + s_ * 16 * 512 + vs_ + (vb_ >> 2) * 256 + 8 * 512); } } while (0)
                            s16x4 cur[8];
                            __builtin_amdgcn_sched_barrier(0);
#pragma unroll
                            for (int g = 0; g < 4; ++g) {
                                VLD(cur, g);
#pragma unroll
                                for (int i = 0; i < 4; ++i) { const int vb = 4 * (g & 1) + i;
                                    const bf16x8 af = {cur[2 * i][0], cur[2 * i][1], cur[2 * i][2], cur[2 * i][3], cur[2 * i + 1][0], cur[2 * i + 1][1], cur[2 * i + 1][2], cur[2 * i + 1][3]};
                                    O[vb] = mfma32(af, pf[g >> 1], O[vb]); }
                            }
#undef VLD
                        }
                    }
                }
            }
            if (t + 2 < NT) asm volatile("s_waitcnt vmcnt(6)" ::: "memory"); else asm volatile("s_waitcnt vmcnt(0)" ::: "memory");
            __syncthreads();
            bb = (bb == 2) ? 0 : bb + 1;
        }
        const float ltot = lrun + __shfl_xor(lrun, 32); const float inv = __builtin_amdgcn_rcpf(ltot);
        int tle = tid_in; asm volatile("" : "+v"(tle));
        const int hl = (tle >> 5) & 1; const size_t grow = (size_t)b * SEQL + q0 + 32 * w + (tle & 31);
        bf16_t* stash = mix + ((size_t)(blockIdx.x * 8 + w) * 16) * 512 + (tle & 63) * 8;
        if (j == 0) {
#pragma unroll
            for (int vb = 0; vb < 8; ++vb) {
                float x[16];
#pragma unroll
                for (int r = 0; r < 16; ++r) x[r] = O[vb][r] * inv;
                u32x4 a, c;
                a.x = cvt_pk_bf16(x[0], x[1]); a.y = cvt_pk_bf16(x[2], x[3]); a.z = cvt_pk_bf16(x[4], x[5]); a.w = cvt_pk_bf16(x[6], x[7]);
                c.x = cvt_pk_bf16(x[8], x[9]); c.y = cvt_pk_bf16(x[10], x[11]); c.z = cvt_pk_bf16(x[12], x[13]); c.w = cvt_pk_bf16(x[14], x[15]);
                *(u32x4*)(stash + (2 * vb) * 512) = a; *(u32x4*)(stash + (2 * vb + 1) * 512) = c;
            }
        } else {
            float ss = 0.f; float ov[128];
#pragma unroll
            for (int vb = 0; vb < 8; ++vb) {
                const u32x4 a = *(const u32x4*)(stash + (2 * vb) * 512), c = *(const u32x4*)(stash + (2 * vb + 1) * 512);
                const float o1[16] = {bflo(a.x), bfhi(a.x), bflo(a.y), bfhi(a.y), bflo(a.z), bfhi(a.z), bflo(a.w), bfhi(a.w), bflo(c.x), bfhi(c.x), bflo(c.y), bfhi(c.y), bflo(c.z), bfhi(c.z), bflo(c.w), bfhi(c.w)};
                const float li = lam * inv;
#pragma unroll
                for (int r = 0; r < 16; ++r) { const float o = o1[r] - li * O[vb][r]; ov[vb * 16 + r] = o; ss += o * o; }
            }
            const float sst = ss + __shfl_xor(ss, 32);
            const float rstd = rsqrtf(sst * (1.f / 256.f) + 1e-6f) * oscale;
            asm volatile("s_waitcnt vmcnt(0)" ::: "memory");
            const bf16_t* gp = proj + grow * 8192 + 6144 + h * 256; bf16_t* op = (bf16_t*)proj + grow * 8192 + 6144 + h * 256;
            u32x2 ggv[32];
#pragma unroll
            for (int i = 0; i < 32; ++i) ggv[i] = *(const u32x2*)(gp + 32 * (i >> 2) + 8 * (i & 3) + 4 * hl);
            const float* sln = (const float*)(lds + SUBLN_OFF);
#pragma unroll
            for (int vb = 0; vb < 8; ++vb)
#pragma unroll
                for (int rg = 0; rg < 4; ++rg) {
                    const int e = 32 * vb + 8 * rg + 4 * hl;
                    const u32x2 gg = ggv[4 * vb + rg]; const f32x4 sg = *(const f32x4*)(sln + e);
                    u32x2 wv; wv.x = cvt_pk_bf16(ov[vb * 16 + 4 * rg] * rstd * sg[0] * bflo(gg.x), ov[vb * 16 + 4 * rg + 1] * rstd * sg[1] * bfhi(gg.x));
                    wv.y = cvt_pk_bf16(ov[vb * 16 + 4 * rg + 2] * rstd * sg[2] * bflo(gg.y), ov[vb * 16 + 4 * rg + 3] * rstd * sg[3] * bfhi(gg.y));
                    *(u32x2*)(op + e) = wv;
                }
        }
    }
}


typedef __attribute__((address_space(1))) unsigned gu32;
#define RLX_AGENT __ATOMIC_RELAXED, __HIP_MEMORY_SCOPE_AGENT
#define XB_TMO      128
#define XB_XCNT(j)  (256  + 64 * (j))
#define XB_XSUB(j)  (1280 + 64 * (j))
#define XB_XGEN(j)  (2304 + 64 * (j))
#define XB_TOP      3328
#define XB_TOPGEN   3392
#define XCD_BAR_WORDS 3456
#define XB_SPIN_CAP (1u << 18)

__device__ __forceinline__ unsigned xb_ld(unsigned* p)              { return __hip_atomic_load(p, __ATOMIC_RELAXED, __HIP_MEMORY_SCOPE_AGENT); }
__device__ __forceinline__ unsigned xb_add(unsigned* p, unsigned v) { return __hip_atomic_fetch_add(p, v, __ATOMIC_RELAXED, __HIP_MEMORY_SCOPE_AGENT); }
__device__ __forceinline__ unsigned xb_xcc_id() { return (unsigned)__builtin_amdgcn_s_getreg((3 << 11) | 20) & 0xFu; }
#define XB_SPIN(cond, bar) do { unsigned _sp = 0; while (cond) { __builtin_amdgcn_s_sleep(1); \
    if ((++_sp & 255u) == 0u) { if (xb_ld(&(bar)[XB_TMO])) break; if (_sp > XB_SPIN_CAP) { atomicAdd(&(bar)[XB_TMO], 1u); break; } } } } while (0)

struct XcdBarrier {
    unsigned* bar; unsigned x;
    volatile LAS unsigned* st;
};

__device__ __forceinline__ XcdBarrier xcd_barrier_post(unsigned* bar, volatile LAS unsigned* st) {
    XcdBarrier b; b.bar = bar; b.x = xb_xcc_id(); b.st = st;
    if (threadIdx.x == 0) (void)xb_add(&bar[XB_XCNT(b.x)], 1u);
    return b;
}
__device__ __forceinline__ void xcd_barrier_complete(unsigned* bar, unsigned x, unsigned& nloc, unsigned& nx) {
    const unsigned G = gridDim.x * gridDim.y * gridDim.z;
    unsigned sum, cnt, mine, sp = 0u;
    for (;;) {
        sum = 0u; cnt = 0u; mine = 0u;
#pragma unroll
        for (unsigned j = 0; j < 16; ++j) { const unsigned c = xb_ld(&bar[XB_XCNT(j)]); sum += c; cnt += (c > 0u) ? 1u : 0u; mine = (j == x) ? c : mine; }
        if (sum == G) break;
        __builtin_amdgcn_s_sleep(1);
        if ((++sp & 255u) == 0u) { if (xb_ld(&bar[XB_TMO])) break; if (sp > XB_SPIN_CAP) { atomicAdd(&bar[XB_TMO], 1u); break; } }
    }
    nloc = mine > 0u ? mine : 1u; nx = cnt > 0u ? cnt : 1u;
}

__device__ __forceinline__ void xcd_barrier(const XcdBarrier& b) {
    asm volatile("s_waitcnt vmcnt(0)" ::: "memory");
    __syncthreads();
    if (threadIdx.x == 0) {
        unsigned* bar = b.bar;
        __builtin_amdgcn_s_waitcnt(0);
        unsigned nloc = b.st[0], nx = b.st[1];
        if (nloc == 0u) { xcd_barrier_complete(bar, b.x, nloc, nx); b.st[0] = nloc; b.st[1] = nx; }
        const unsigned old = xb_add(&bar[XB_XSUB(b.x)], 1u);
        const unsigned gen = old / nloc;
        if (old + 1u == (gen + 1u) * nloc) {
            __builtin_amdgcn_fence(__ATOMIC_RELEASE, "agent");
            asm volatile("s_waitcnt vmcnt(0)" ::: "memory");
            const unsigned og = xb_add(&bar[XB_TOP], 1u);
            const unsigned tg = og / nx;
            if (og + 1u == (tg + 1u) * nx) xb_add(&bar[XB_TOPGEN], 1u);
            else XB_SPIN(xb_ld(&bar[XB_TOPGEN]) == tg, bar);
            __builtin_amdgcn_fence(__ATOMIC_ACQUIRE, "agent");
            xb_add(&bar[XB_XGEN(b.x)], 1u);
            asm volatile("s_waitcnt vmcnt(0)" ::: "memory");
        } else {
            XB_SPIN(xb_ld(&bar[XB_XGEN(b.x)]) == gen, bar);
            __builtin_amdgcn_fence(__ATOMIC_ACQUIRE, "agent");
            asm volatile("s_waitcnt vmcnt(0)" ::: "memory");
        }
    }
    __syncthreads();
}

struct Params { const float* in[27]; float* out; unsigned char* ws; int ph_lo, ph_hi; };
constexpr int N_PHASES = 16;

__global__ void __launch_bounds__(512, 2) mega_fwd(Params P) {
    extern __shared__ __attribute__((aligned(16))) unsigned char lds[];
    cg::grid_group grid = cg::this_grid();
    const int lo = P.ph_lo, hi = P.ph_hi;
    volatile LAS unsigned* MISC = (volatile LAS unsigned*)((LAS unsigned char*)lds + (LDS_BYTES - 64));
    if (threadIdx.x < 2) MISC[threadIdx.x] = 0u;
    __syncthreads();
    const XcdBarrier bar = xcd_barrier_post((unsigned*)P.ws, MISC);
#ifndef PHMASK
#define PHMASK 0xffff
#endif
#define IN(k) (((PHMASK >> (k)) & 1) && lo <= (k) && (k) < hi)
#ifndef DUPMASK
#define DUPMASK 0
#endif
#define DUP(k) ((DUPMASK >> (k)) & 1)
#define SEAM(k) do { if (IN(k) && IN((k) + 1)) { if ((k) == 0) grid.sync(); else xcd_barrier(bar); } } while (0)
#define FRAME() \
    int tid = threadIdx.x; asm volatile("" : "+v"(tid)); \
    const int lane = tid & 63, wave = tid >> 6; \
    int G = gridDim.x, bx = blockIdx.x; asm volatile("" : "+s"(G), "+s"(bx)); \
    const int vcu = (G % 8 == 0) ? (bx % 8) * (G / 8) + bx / 8 : bx; \
    __attribute__((address_space(1))) unsigned char* wsg_ = (__attribute__((address_space(1))) unsigned char*)P.ws; asm volatile("" : "+s"(wsg_)); unsigned char* ws = (unsigned char*)wsg_; \
    bf16_t* XN = (bf16_t*)(ws + WS_XN); bf16_t* PROJ = (bf16_t*)(ws + WS_PROJ); bf16_t* YAP = (bf16_t*)(ws + WS_YAP); bf16_t* XA2 = (bf16_t*)(ws + WS_PROJ + 192 * MiB); (void)XA2; \
    const int gw = vcu * 8 + wave, NGW = G * 8; \
    (void)lane; (void)gw; (void)NGW; (void)XN; (void)PROJ; (void)YAP;
#define SSQ(k) ((float*)(ws + 65536 + (k) * 65536))

    if (IN(0)) {
        FRAME();
        for (int it = vcu; it < 4480; it += G) {
            int r = it; const int jl = r / 2240; r -= jl * 2240;
            unsigned char* wb = ws + WS_W + jl * W_PER;
            if (r < 640) { transpose_block(P.in[2] + (size_t)jl * 2048 * 5120, 2048, 5120, (bf16_t*)(wb + W_INE), (float*)lds, r, tid, P.in[1] + jl * 2048); continue; } r -= 640;
            if (r < 64) { transpose_block(P.in[11] + (size_t)jl * 1024 * 1024, 1024, 1024, (bf16_t*)(wb + W_GLU), (float*)lds, r, tid, nullptr); continue; } r -= 64;
            if (r < 256) { transpose_block(P.in[17] + (size_t)jl * 2048 * 2048, 2048, 2048, (bf16_t*)(wb + W_OUTE), (float*)lds, r, tid, nullptr); continue; } r -= 256;
            if (r < 1024) { transpose_block(P.in[19] + (size_t)jl * 2048 * 8192, 2048, 8192, (bf16_t*)(wb + W_INO), (float*)lds, r, tid, P.in[18] + jl * 2048); continue; } r -= 1024;
            transpose_block(P.in[25] + (size_t)jl * 2048 * 2048, 2048, 2048, (bf16_t*)(wb + W_OUTO), (float*)lds, r, tid, nullptr);
        }
        { int m = gw;
          for (; m + 3 * NGW < MROWS; m += 4 * NGW) xb_rows4(P.in[0], XN, SSQ(0), m, NGW, lane);
          for (; m < MROWS; m += NGW) xb_row(P.in[0] + (size_t)m * DM, XN + (size_t)m * DM, SSQ(0) + m, lane); }
        for (int i = bx * 512 + tid; i < 32768; i += G * 512) {
            const int idx = i * 8, sp = idx & 127, t = (idx >> 7) & 127;
            const f32x4 w0 = *(const f32x4*)(P.in[15] + idx), w1 = *(const f32x4*)(P.in[15] + idx + 4);
            float wv[8] = {w0[0], w0[1], w0[2], w0[3], w1[0], w1[1], w1[2], w1[3]};
#pragma unroll
            for (int e = 0; e < 8; ++e) if (sp + e > t) wv[e] = 0.f;
            *(bf16x8*)((bf16_t*)(ws + 524288) + idx) = pack8(wv);
        }
        for (int i = bx * 512 + tid; i < 65536; i += G * 512) {
            const int pos = i >> 4, fi = i & 15;
            const float invf = (float)exp2(-(double)fi * (18.931568569324174 / 16.0));
            const float ang = (float)pos * invf; float s, c; sincos_red((double)ang, s, c);
            ((float*)(ws + WS_ROPE))[i] = c; ((float*)(ws + WS_ROPE))[65536 + i] = s;
        }
        __syncthreads();
        for (int combo = bx; combo < 128; combo += G)
            s5_tables(combo >> 6, combo & 63, P.in[3], P.in[4], P.in[5], P.in[6], P.in[7], P.in[8], P.in[9], P.in[10], ws, (float*)lds, tid);
    }
    SEAM(0);

#define OUT_PROJ(PH, AOP, LDA, WOFF, XRES, LAST, SQ) \
    if (IN(PH)) { FRAME(); \
        pg8::Gemm g{AOP, (const bf16_t*)(ws + WS_W + WOFF), MROWS, 2048, 2048, LDA}; pg8::StaticOrder S; S.init(MROWS, 2048, G, bx); \
        if (LAST) { pg8::EpiResid E{XRES, P.out}; pg8::gemm_phase<pg8::EpiResid, pg8::StaticOrder, true, true>((LAS unsigned char*)lds, g, S, E, tid); } \
        else { pg8::EpiResidStat E{XRES, P.out, XN, SSQ(SQ)}; pg8::gemm_phase<pg8::EpiResidStat, pg8::StaticOrder, true, true>((LAS unsigned char*)lds, g, S, E, tid); } } \
    SEAM(PH);

#define EVEN_LAYER(PH0, JL, XRES, SQ) \
    if (IN(PH0)) { FRAME(); \
        pg8::Gemm g{XN, (const bf16_t*)(ws + WS_W + (JL) * W_PER + W_INE), MROWS, 5120, 2048, 2048}; pg8::StaticOrder S; S.init(MROWS, 5120, G, bx); \
        pg8::EpiEvenProj E{PROJ, SSQ(SQ), XA2}; \
        pg8::gemm_phase<pg8::EpiEvenProj, pg8::StaticOrder, true, true>((LAS unsigned char*)lds, g, S, E, tid); } \
    SEAM(PH0); \
    if (IN(PH0 + 1)) { FRAME(); \
        for (int it = vcu; it < 256; it += G) { const int b = it >> 6, g = it & 63; \
            s5_item(b, g, ws + WS_S5 + (size_t)((JL) * 64 + g) * 262144, (const float*)(ws + WS_AT) + ((JL) * 64 + g) * 128, XA2, YAP, lds, tid); } \
        for (int it = vcu; it < 256; it += G) { const int b = it >> 6, nc = (it >> 1) & 31, gh = it & 1; \
            sgu_item(b, nc, gh, PROJ, XN, P.in[13] + (JL) * 1024, P.in[14] + (JL) * 1024, (const bf16_t*)(ws + 524288) + (size_t)(JL) * 8 * 128 * 128, P.in[16] + (JL) * 1024, lds, tid); } } \
    SEAM(PH0 + 1); \
    if (IN(PH0 + 2)) { FRAME(); \
        pg8::Gemm g{YAP, (const bf16_t*)(ws + WS_W + (JL) * W_PER + W_GLU), MROWS, 1024, 1024, 1024}; pg8::StaticOrder S; S.init(MROWS, 1024, G, bx); \
        pg8::EpiGlu E{YAP, PROJ, P.in[12] + (JL) * 1024, PROJ + 1024}; \
        pg8::gemm_phase<pg8::EpiGlu, pg8::StaticOrder, true, true>((LAS unsigned char*)lds, g, S, E, tid); } \
    SEAM(PH0 + 2); \
    OUT_PROJ(PH0 + 3, PROJ + 1024, 5120, (JL) * W_PER + W_OUTE, XRES, false, (SQ) + 1)

#define ODD_LAYER(PH0, JL, LAYER, LAST, SQ) \
    if (IN(PH0)) { FRAME(); \
        pg8::Gemm g{XN, (const bf16_t*)(ws + WS_W + (JL) * W_PER + W_INO), MROWS, 8192, 2048, 2048}; pg8::StaticOrder S; S.init(MROWS, 8192, G, bx); \
        pg8::EpiOddProj E{PROJ, (const float*)(ws + WS_ROPE), SSQ(SQ)}; \
        pg8::gemm_phase<pg8::EpiOddProj, pg8::StaticOrder, true, true>((LAS unsigned char*)lds, g, S, E, tid); } \
    SEAM(PH0); \
    if (IN(PH0 + 1)) { FRAME(); \
        float d1 = 0.f, d2 = 0.f; \
        for (int i = 0; i < 128; ++i) { d1 += P.in[20][(JL) * 128 + i] * P.in[21][(JL) * 128 + i]; d2 += P.in[22][(JL) * 128 + i] * P.in[23][(JL) * 128 + i]; } \
        const float lam_init = 0.8f - 0.6f * expf(-0.3f * (float)(LAYER)); \
        const float lam = expf(d1) - expf(d2) + lam_init; \
        if (tid < 256) ((float*)(lds + SUBLN_OFF))[tid] = (P.in[24] + (JL) * 256)[tid]; \
        __syncthreads(); \
        for (int it = vcu; it < 256; it += G) { const int b = it >> 6, h = (it >> 3) & 7, x = it & 7; \
            attn_unit(b, h, 15 - x, PROJ, XN, lam, P.in[24] + (JL) * 256, 1.f - lam_init, lds, tid); \
            attn_unit(b, h, x, PROJ, XN, lam, P.in[24] + (JL) * 256, 1.f - lam_init, lds, tid); } } \
    SEAM(PH0 + 1); \
    OUT_PROJ(PH0 + 2, PROJ + 6144, 8192, (JL) * W_PER + W_OUTO, P.out, LAST, (SQ) + 1)

    EVEN_LAYER(1, 0, P.in[0], 0)
    ODD_LAYER(5, 0, 1, false, 1)
    EVEN_LAYER(8, 1, P.out, 2)
    ODD_LAYER(12, 1, 3, true, 3)
    if (IN(15)) { FRAME();
        int m = gw;
        for (; m + 3 * NGW < MROWS; m += 4 * NGW) rms_rows4_final(P.out, m, NGW, P.in[26], lane);
        for (; m < MROWS; m += NGW) rms_row<true>(P.out + (size_t)m * DM, P.in[26], nullptr, P.out + (size_t)m * DM, lane); }
#undef IN
#undef SEAM
#undef FRAME
}


extern "C" void kernel_launch(void* const* d_in, const int* in_sizes, int n_in, void* d_out, int out_size, void* d_ws, size_t ws_size, hipStream_t stream) {
    static int grid = 0;
    if (grid == 0) {
        if (n_in != 27 || ws_size < WS_END) { fprintf(stderr, "kernel_launch: unexpected n_in %d or ws_size %zu\n", n_in, ws_size); grid = -1; return; }
        int dev = 0, cus = 0, per_cu = 0;
        hipGetDevice(&dev); hipDeviceGetAttribute(&cus, hipDeviceAttributeMultiprocessorCount, dev);
        hipFuncSetAttribute((const void*)mega_fwd, hipFuncAttributeMaxDynamicSharedMemorySize, LDS_BYTES);
        hipOccupancyMaxActiveBlocksPerMultiprocessor(&per_cu, (const void*)mega_fwd, 512, LDS_BYTES);
        if (per_cu < 1) { fprintf(stderr, "kernel_launch: occupancy query says %d blocks per CU\n", per_cu); per_cu = 1; }
        (void)hipGetLastError();
        grid = cus * 1;
    }
    if (grid < 0) return;
    if (hipMemsetAsync(d_ws, 0, 524288, stream) != hipSuccess) { fprintf(stderr, "kernel_launch: memset failed\n"); return; }
    Params p{};
    for (int i = 0; i < 27; ++i) p.in[i] = (const float*)d_in[i];
    p.out = (float*)d_out; p.ws = (unsigned char*)d_ws; p.ph_lo = 0; p.ph_hi = N_PHASES;
    void* args[] = {&p};
    hipError_t e = hipLaunchCooperativeKernel((const void*)mega_fwd, dim3(grid), dim3(512), args, LDS_BYTES, stream);
    if (e != hipSuccess) fprintf(stderr, "cooperative launch failed: %s (grid %d)\n", hipGetErrorString(e), grid);
}
```
